# Optimizing an MI355X kernel written in HIP

```python
import math
import jax, jax.numpy as jnp
from jax import lax
import numpy as np

D_MODEL = 1024
BATCH = 8
SEQ = 2048
DEPTH = 1
DEC_BATCH = 128
DEC_SEQ = 1
PAST_LEN = 2048
PAGE_SIZE = 128

C_CONV = D_MODEL // 2
CONV_WIDTH = 31
N_HEADS = 8
HEAD_DIM = (D_MODEL - C_CONV) // N_HEADS
N_KV_HEADS = 2
GROUP = N_HEADS // N_KV_HEADS
KV_W = N_KV_HEADS * HEAD_DIM
N_KV_SLOTS = 6
N_PAGED_SLOTS = 4
MIX_WIDTH = C_CONV + N_HEADS * HEAD_DIM
IN_COLS = 2 * C_CONV + N_HEADS * HEAD_DIM + N_KV_SLOTS * KV_W + 3 * N_HEADS
D_FF = 4 * D_MODEL
CMP_BLOCK = 32
SEL_BLOCK = 64
TOP_N = 16
N_LOCAL = 2
WINDOW = 512
WIN_Q_BLOCK = 128
SEL_Q_BLOCK = 64
FORCE_BONUS = float(GROUP + 1)
NEG_INF = -1e30
RMS_EPS = 1e-6
LN_EPS = 1e-5
ATTN_SCALE = HEAD_DIM ** -0.5

kernel_name = 'hymba_conformer_nsa_decoder_step'


def rms_norm(x, g):
    xf = x.astype(jnp.float32)
    y = xf * lax.rsqrt(jnp.mean(xf * xf, axis=-1, keepdims=True) + RMS_EPS)
    return (y * g.astype(jnp.float32)).astype(x.dtype)


def layer_norm(x, g, b):
    xf = x.astype(jnp.float32)
    mu = jnp.mean(xf, axis=-1, keepdims=True)
    var = jnp.mean(jnp.square(xf - mu), axis=-1, keepdims=True)
    y = (xf - mu) * lax.rsqrt(var + LN_EPS) * g.astype(jnp.float32) + b.astype(jnp.float32)
    return y.astype(x.dtype)


def masked_softmax(s, mask):
    p = jax.nn.softmax(jnp.where(mask, s, NEG_INF), axis=-1)
    return jnp.where(mask, p, 0.0)


def project(x, g, w_in):
    B, L, _ = x.shape
    z = rms_norm(x, g) @ w_in
    c0 = 2 * C_CONV
    c1 = c0 + N_HEADS * HEAD_DIM
    c2 = c1 + N_KV_SLOTS * KV_W
    u = z[..., :c0]
    q = z[..., c0:c1].reshape(B, L, N_KV_HEADS, GROUP, HEAD_DIM)
    kv = z[..., c1:c2].reshape(B, L, N_KV_SLOTS, N_KV_HEADS, HEAD_DIM)
    gl = z[..., c2:].reshape(B, L, N_HEADS, 3)
    return u, q, kv, gl


def conv_mixer(u, prev, w_dw, b_dw, ln_g, ln_b):
    a, b = jnp.split(u, 2, axis=-1)
    glu = a * jax.nn.sigmoid(b)
    ext = jnp.concatenate([prev.astype(glu.dtype), glu], axis=1)
    y = lax.conv_general_dilated(ext, w_dw[:, None, :].astype(glu.dtype), window_strides=(1,),
                                 padding='VALID', dimension_numbers=('NWC', 'WIO', 'NWC'),
                                 feature_group_count=C_CONV)
    y = layer_norm(y + b_dw, ln_g, ln_b)
    return jax.nn.silu(y), ext[:, -(CONV_WIDTH - 1):]


def compressed_selected(q, q_pos, k_cmp, v_cmp, k_sel, v_sel, w_ck, w_cv):
    B, Q = q.shape[0], q.shape[1]
    T = k_cmp.shape[1]
    t_pad = -(-T // SEL_BLOCK) * SEL_BLOCK
    padw = ((0, 0), (0, t_pad - T), (0, 0), (0, 0))
    k_cmp, v_cmp, k_sel, v_sel = [jnp.pad(a, padw) for a in (k_cmp, v_cmp, k_sel, v_sel)]
    n_cmp = t_pad // CMP_BLOCK
    n_blk = t_pad // SEL_BLOCK
    kc = jnp.einsum('bcjhd,jh->bchd', k_cmp.reshape(B, n_cmp, CMP_BLOCK, N_KV_HEADS, HEAD_DIM), w_ck)
    vc = jnp.einsum('bcjhd,jh->bchd', v_cmp.reshape(B, n_cmp, CMP_BLOCK, N_KV_HEADS, HEAD_DIM), w_cv)
    s = jnp.einsum('bqhgd,bchd->bqhgc', q, kc).astype(jnp.float32) * ATTN_SCALE
    c_end = (jnp.arange(n_cmp, dtype=jnp.int32) + 1) * CMP_BLOCK - 1
    cmask = c_end[None, :] <= q_pos[:, None]
    p = masked_softmax(s, cmask[None, :, None, None, :])
    o_cmp = jnp.einsum('bqhgc,bchd->bqhgd', p.astype(vc.dtype), vc)
    p_blk = p.sum(axis=3).reshape(B, Q, N_KV_HEADS, n_blk, SEL_BLOCK // CMP_BLOCK).sum(-1)
    blk = jnp.arange(n_blk, dtype=jnp.int32)
    back = (q_pos // SEL_BLOCK)[:, None] - blk[None, :]
    forced = (blk[None, :] == 0) | ((back >= 0) & (back < N_LOCAL))
    valid = back >= 0
    score = jnp.where(valid[None, :, None, :],
                      p_blk + jnp.where(forced, FORCE_BONUS, 0.0)[None, :, None, :], -jnp.inf)
    n_top = min(TOP_N, n_blk)
    _, idx = lax.top_k(score, n_top)
    kb = k_sel.reshape(B, n_blk, SEL_BLOCK, N_KV_HEADS, HEAD_DIM).transpose(0, 3, 1, 2, 4)
    vb = v_sel.reshape(B, n_blk, SEL_BLOCK, N_KV_HEADS, HEAD_DIM).transpose(0, 3, 1, 2, 4)
    qb = Q if Q <= SEL_Q_BLOCK else math.gcd(Q, SEL_Q_BLOCK)
    nqb = Q // qb
    take = jax.vmap(jax.vmap(lambda a, i: a[i]))
    n_keys = n_top * SEL_BLOCK

    def sel_block(args):
        q_b, i_b, pos_b = args
        it = jnp.swapaxes(i_b, 1, 2)
        kg = take(kb, it)
        vg = take(vb, it).reshape(B, N_KV_HEADS, qb, n_keys, HEAD_DIM)
        s_b = jnp.einsum('bqhgd,bhqnsd->bqhgns', q_b, kg).astype(jnp.float32) * ATTN_SCALE
        kpos = i_b[..., None] * SEL_BLOCK + jnp.arange(SEL_BLOCK, dtype=jnp.int32)
        m = (kpos <= pos_b[None, :, None, None, None]).reshape(B, qb, N_KV_HEADS, 1, n_keys)
        p_b = masked_softmax(s_b.reshape(B, qb, N_KV_HEADS, GROUP, n_keys), m)
        return jnp.einsum('bqhgk,bhqkd->bqhgd', p_b.astype(vg.dtype), vg)

    xs = (jnp.swapaxes(q.reshape(B, nqb, qb, N_KV_HEADS, GROUP, HEAD_DIM), 0, 1),
          jnp.swapaxes(idx.reshape(B, nqb, qb, N_KV_HEADS, n_top), 0, 1),
          q_pos.reshape(nqb, qb))
    o_sel = lax.map(sel_block, xs)
    o_sel = jnp.swapaxes(o_sel, 0, 1).reshape(B, Q, N_KV_HEADS, GROUP, HEAD_DIM)
    return o_cmp, o_sel


def window_attend(q, q_pos, k, v, k_pos):
    rel = q_pos[:, None] - k_pos[None, :]
    m = (rel >= 0) & (rel <= WINDOW) & (k_pos[None, :] >= 0)
    s = jnp.einsum('bqhgd,bkhd->bqhgk', q, k).astype(jnp.float32) * ATTN_SCALE
    p = masked_softmax(s, m[None, :, None, None, :])
    return jnp.einsum('bqhgk,bkhd->bqhgd', p.astype(v.dtype), v)


def window_prompt(q, k, v):
    B, S = q.shape[0], q.shape[1]
    qb = math.gcd(S, WIN_Q_BLOCK)
    padw = ((0, 0), (WINDOW, 0), (0, 0), (0, 0))
    kp, vp = jnp.pad(k, padw), jnp.pad(v, padw)
    r = jnp.arange(qb + WINDOW, dtype=jnp.int32)
    a = jnp.arange(qb, dtype=jnp.int32)

    def blk(start):
        return window_attend(lax.dynamic_slice_in_dim(q, start, qb, axis=1), start + a,
                             lax.dynamic_slice_in_dim(kp, start, qb + WINDOW, axis=1),
                             lax.dynamic_slice_in_dim(vp, start, qb + WINDOW, axis=1),
                             start - WINDOW + r)

    o = lax.map(blk, jnp.arange(S // qb, dtype=jnp.int32) * qb)
    return jnp.swapaxes(o, 0, 1).reshape(B, S, N_KV_HEADS, GROUP, HEAD_DIM)


def gate_merge(o_cmp, o_sel, o_win, gl):
    B, L = o_cmp.shape[0], o_cmp.shape[1]
    g = jax.nn.sigmoid(gl.astype(jnp.float32)).astype(o_cmp.dtype)
    hd = lambda o: o.reshape(B, L, N_HEADS, HEAD_DIM)
    o = hd(o_cmp) * g[..., 0:1] + hd(o_sel) * g[..., 1:2] + hd(o_win) * g[..., 2:3]
    return o.reshape(B, L, N_HEADS * HEAD_DIM)


def residual_block(x, conv_y, attn_y, w_out, g_mlp, w_up, w_down):
    h = x + jnp.concatenate([conv_y, attn_y], axis=-1) @ w_out
    m = rms_norm(h, g_mlp) @ w_up
    return h + jnp.square(jax.nn.relu(m)) @ w_down


def setup_inputs(seed: int = 0) -> dict:
    key = jax.random.key(seed)
    ks = jax.random.split(key, 24)
    f32 = jnp.float32
    nrm = lambda k, shape, s=1.0: jax.random.normal(k, shape, f32) * s
    n_pages = PAST_LEN // PAGE_SIZE
    n_used = DEC_BATCH * n_pages
    n_phys = n_used + (n_used + 3) // 4
    w_buf = min(WINDOW, PAST_LEN)
    page_table = jax.random.permutation(ks[5], n_phys)[:n_used].reshape(DEC_BATCH, n_pages).astype(jnp.int32)
    return {
        'x_prompt': nrm(ks[0], (BATCH, SEQ, D_MODEL)),
        'x_sample': nrm(ks[1], (DEC_BATCH, DEC_SEQ, D_MODEL)),
        'cache_kv': nrm(ks[2], (DEPTH, n_phys, PAGE_SIZE, N_PAGED_SLOTS, N_KV_HEADS, HEAD_DIM)),
        'cache_win': nrm(ks[3], (DEPTH, DEC_BATCH, w_buf, 2, N_KV_HEADS, HEAD_DIM)),
        'state_conv': nrm(ks[4], (DEPTH, DEC_BATCH, CONV_WIDTH - 1, C_CONV), 0.5),
        'page_table': page_table,
        'g_attn_norm': 1.0 + nrm(ks[6], (DEPTH, D_MODEL), 0.05),
        'w_in': nrm(ks[7], (DEPTH, D_MODEL, IN_COLS), D_MODEL ** -0.5),
        'w_dw': nrm(ks[8], (DEPTH, CONV_WIDTH, C_CONV), CONV_WIDTH ** -0.5),
        'b_dw': nrm(ks[9], (DEPTH, C_CONV), 0.02),
        'conv_ln_g': 1.0 + nrm(ks[10], (DEPTH, C_CONV), 0.05),
        'conv_ln_b': nrm(ks[11], (DEPTH, C_CONV), 0.02),
        'w_cmp_k': (1.0 + nrm(ks[12], (DEPTH, CMP_BLOCK, N_KV_HEADS), 0.3)) * CMP_BLOCK ** -0.5,
        'w_cmp_v': (1.0 + nrm(ks[13], (DEPTH, CMP_BLOCK, N_KV_HEADS), 0.3)) * CMP_BLOCK ** -0.5,
        'w_out': nrm(ks[14], (DEPTH, MIX_WIDTH, D_MODEL), MIX_WIDTH ** -0.5),
        'g_mlp_norm': 1.0 + nrm(ks[15], (DEPTH, D_MODEL), 0.05),
        'w_up': nrm(ks[16], (DEPTH, D_MODEL, D_FF), D_MODEL ** -0.5),
        'w_down': nrm(ks[17], (DEPTH, D_FF, D_MODEL), D_FF ** -0.5),
        'g_final': 1.0 + nrm(ks[18], (D_MODEL,), 0.05),
    }


def reference(x_prompt, x_sample, cache_kv, cache_win, state_conv, page_table, g_attn_norm, w_in, w_dw, b_dw,
              conv_ln_g, conv_ln_b, w_cmp_k, w_cmp_v, w_out, g_mlp_norm, w_up, w_down, g_final):
    hp, hs = x_prompt, x_sample
    w_buf = cache_win.shape[2]
    q_pos_p = jnp.arange(SEQ, dtype=jnp.int32)
    q_pos_s = PAST_LEN + jnp.arange(DEC_SEQ, dtype=jnp.int32)
    k_pos_win_s = PAST_LEN - w_buf + jnp.arange(w_buf + DEC_SEQ, dtype=jnp.int32)
    kv_p, win_p, conv_p, kv_s, win_s, conv_s = [], [], [], [], [], []
    for l in range(DEPTH):
        u, q, kv, gl = project(hp, g_attn_norm[l], w_in[l])
        zeros = jnp.zeros((BATCH, CONV_WIDTH - 1, C_CONV), u.dtype)
        conv_y, conv_st = conv_mixer(u, zeros, w_dw[l], b_dw[l], conv_ln_g[l], conv_ln_b[l])
        o_cmp, o_sel = compressed_selected(q, q_pos_p, kv[:, :, 0], kv[:, :, 1], kv[:, :, 2], kv[:, :, 3],
                                           w_cmp_k[l], w_cmp_v[l])
        o_win = window_prompt(q, kv[:, :, 4], kv[:, :, 5])
        hp = residual_block(hp, conv_y, gate_merge(o_cmp, o_sel, o_win, gl), w_out[l], g_mlp_norm[l], w_up[l], w_down[l])
        kv_p.append(kv[:, :, :N_PAGED_SLOTS])
        win_p.append(kv[:, -min(WINDOW, SEQ):, N_PAGED_SLOTS:])
        conv_p.append(conv_st)
        u, q, kv, gl = project(hs, g_attn_norm[l], w_in[l])
        conv_y, conv_st = conv_mixer(u, state_conv[l], w_dw[l], b_dw[l], conv_ln_g[l], conv_ln_b[l])
        past = jnp.take(cache_kv[l], page_table, axis=0).reshape(DEC_BATCH, PAST_LEN, N_PAGED_SLOTS, N_KV_HEADS, HEAD_DIM)
        full = jnp.concatenate([past, kv[:, :, :N_PAGED_SLOTS].astype(past.dtype)], axis=1)
        o_cmp, o_sel = compressed_selected(q, q_pos_s, full[:, :, 0], full[:, :, 1], full[:, :, 2], full[:, :, 3],
                                           w_cmp_k[l], w_cmp_v[l])
        win = jnp.concatenate([cache_win[l].astype(kv.dtype), kv[:, :, N_PAGED_SLOTS:]], axis=1)
        o_win = window_attend(q, q_pos_s, win[:, :, 0], win[:, :, 1], k_pos_win_s)
        hs = residual_block(hs, conv_y, gate_merge(o_cmp, o_sel, o_win, gl), w_out[l], g_mlp_norm[l], w_up[l], w_down[l])
        kv_s.append(kv[:, :, :N_PAGED_SLOTS])
        win_s.append(win[:, -w_buf:])
        conv_s.append(conv_st)
    y_prompt = rms_norm(hp, g_final)
    y_sample = rms_norm(hs, g_final)
    return (y_prompt, y_sample, jnp.stack(kv_p), jnp.stack(win_p), jnp.stack(conv_p),
            jnp.stack(kv_s), jnp.stack(win_s), jnp.stack(conv_s))
```

```cpp
#include <hip/hip_runtime.h>
#include <cstdio>
#include <cstdint>
namespace pg8 {
#define PG8_LAS __attribute__((address_space(3)))
typedef unsigned short bf16_t;
typedef short bf16x8 __attribute__((ext_vector_type(8)));
typedef float f32x4 __attribute__((ext_vector_type(4)));
typedef unsigned u32x4 __attribute__((ext_vector_type(4)));
constexpr int BM = 256, BK = 64, HALF = 128, HTB = HALF * BK * 2  , STAGE_BYTES = 8 * HTB, NXCD = 8, WGM = 8;

__host__ __device__ __forceinline__ int lds_byte(int r, int c) { const int st = (r >> 4) * 2 + (c >> 5), rr = r & 15, cc = c & 31, ob = rr * 64 + cc * 2; return st * 1024 + (ob ^ (((ob >> 9) & 1) << 5)); }
__host__ __device__ __forceinline__ void stage_rc(int b, int& R, int& C) { const int st = b / 1024, sb = b % 1024, swz = sb ^ (((sb >> 9) & 1) << 5); R = (st >> 1) * 16 + swz / 64; C = (st & 1) * 32 + (swz % 64) / 2; }
__host__ __device__ __forceinline__ int perm32(int rho) { const int n = rho >> 4, i = rho & 15; return 8 * (i >> 2) + 4 * n + (i & 3); }

struct Unit { int pm, pn; };
struct Gemm { const bf16_t* A; const bf16_t* Bt; int M, N, K; };

struct StaticOrder {
    int nM, nN, nwg, G, c;
    __host__ __device__ void init(int M, int N, int G_, int c_) { nM = M / BM; nN = N / BM; nwg = nM * nN; G = G_; c = c_; }
    __host__ __device__ bool next(int i, Unit& u) const {
        const long L = (long)i * G + c; if (L >= nwg) return false;
        int wgid = (int)L; { const int q = nwg / NXCD, r = nwg % NXCD, xcd = wgid % NXCD, off = wgid / NXCD; wgid = (xcd < r ? xcd * (q + 1) : r * (q + 1) + (xcd - r) * q) + off; }
        const int nig = WGM * nN, gid = wgid / nig, fm = gid * WGM, gsz = (nM - fm) < WGM ? (nM - fm) : WGM;
        u.pm = fm + ((wgid % nig) % gsz); u.pn = (wgid % nig) / gsz; return true;
    }
    __device__ __forceinline__ void a_ready(const Unit&) const {}
    __device__ __forceinline__ void done(const Unit&) const {}
};


constexpr int MP = 16384, MS = 128, MALL = 16640;
constexpr int NVALID = MP + MS;
constexpr size_t O_YP = 0, O_YS = 16777216, O_KVP = 16908288, O_WINP = 25296896, O_CONVP = 26345472, O_KVS = 26468352, O_WINS = 26533888, O_CONVS = 43311104, O_END = 45277184;
constexpr float QSCALE = 0.125f * 1.4426950408889634f;

__device__ __forceinline__ unsigned cvt_pk_bf16(float lo, float hi) { unsigned r; asm volatile("v_cvt_pk_bf16_f32 %0, %1, %2" : "=v"(r) : "v"(lo), "v"(hi)); return r; }
__device__ __forceinline__ float fast_sigmoid(float x) { return __builtin_amdgcn_rcpf(1.0f + __builtin_amdgcn_exp2f(-1.4426950408889634f * x)); }
__device__ __forceinline__ u32x4 pack8(const f32x4 a, const f32x4 b) { u32x4 w; w.x = cvt_pk_bf16(a[0], a[1]); w.y = cvt_pk_bf16(a[2], a[3]); w.z = cvt_pk_bf16(b[0], b[1]); w.w = cvt_pk_bf16(b[2], b[3]); return w; }

struct EpiInProj {
    static constexpr bool PERM = true, AFTER_DRAIN = false;
    bf16_t* G; bf16_t* Q; bf16_t* KV; float* GATE; float* out;
    __device__ __forceinline__ void operator()(const f32x4 (&acc)[2][2][4][2], const Unit& u, int wr, int wc, int fr, int fq) const {
        const int pn = u.pn; const int rb = u.pm * BM + wr * 64 + fr; const int cl = wc * 32 + 8 * fq;
        if (pn < 4) {
#pragma unroll
            for (int ai = 0; ai < 2; ++ai)
#pragma unroll
                for (int m = 0; m < 4; ++m) { const int row = rb + ai * HALF + m * 16; if (row >= NVALID) continue;
                    f32x4 g0, g1;
#pragma unroll
                    for (int e = 0; e < 4; ++e) { g0[e] = acc[ai][0][m][0][e] * fast_sigmoid(acc[ai][1][m][0][e]); g1[e] = acc[ai][0][m][1][e] * fast_sigmoid(acc[ai][1][m][1][e]); }
                    const int c = 128 * pn + cl;
                    *(u32x4*)(G + (size_t)row * 512 + c) = pack8(g0, g1);
                    float* dst = nullptr;
                    if (row < MP) { const int t = row & 2047; if (t >= 2018) dst = out + O_CONVP + ((size_t)((row >> 11) * 30 + t - 2018) * 512 + c); }
                    else dst = out + O_CONVS + ((size_t)((row - MP) * 30 + 29) * 512 + c);
                    if (dst) { *(f32x4*)dst = g0; *(f32x4*)(dst + 4) = g1; } }
        } else if (pn < 6) {
#pragma unroll
            for (int ai = 0; ai < 2; ++ai)
#pragma unroll
                for (int m = 0; m < 4; ++m) { const int row = rb + ai * HALF + m * 16;
#pragma unroll
                    for (int bj = 0; bj < 2; ++bj) { const int c = 256 * (pn - 4) + 128 * bj + cl;
                        *(u32x4*)(Q + (size_t)row * 512 + c) = pack8(acc[ai][bj][m][0] * QSCALE, acc[ai][bj][m][1] * QSCALE); } }
        } else if (pn < 8) {
#pragma unroll
            for (int ai = 0; ai < 2; ++ai)
#pragma unroll
                for (int m = 0; m < 4; ++m) { const int row = rb + ai * HALF + m * 16; if (row >= NVALID) continue;
#pragma unroll
                    for (int bj = 0; bj < 2; ++bj) { const int c = 256 * (pn - 6) + 128 * bj + cl;
                        *(u32x4*)(KV + (size_t)row * 768 + c) = pack8(acc[ai][bj][m][0], acc[ai][bj][m][1]);
                        float* dst = (row < MP) ? out + O_KVP + (size_t)row * 512 + c : out + O_KVS + (size_t)(row - MP) * 512 + c;
                        *(f32x4*)dst = acc[ai][bj][m][0]; *(f32x4*)(dst + 4) = acc[ai][bj][m][1]; } }
        } else if (pn == 8) {
#pragma unroll
            for (int ai = 0; ai < 2; ++ai)
#pragma unroll
                for (int m = 0; m < 4; ++m) { const int row = rb + ai * HALF + m * 16; if (row >= NVALID) continue;
#pragma unroll
                    for (int bj = 0; bj < 2; ++bj) { const int c = 128 * bj + cl;
                        *(u32x4*)(KV + (size_t)row * 768 + 512 + c) = pack8(acc[ai][bj][m][0], acc[ai][bj][m][1]);
                        float* dst = nullptr;
                        if (row < MP) { const int t = row & 2047; if (t >= 1536) dst = out + O_WINP + ((size_t)((row >> 11) * 512 + t - 1536) * 256 + c); }
                        else dst = out + O_WINS + ((size_t)((row - MP) * 512 + 511) * 256 + c);
                        if (dst) { *(f32x4*)dst = acc[ai][bj][m][0]; *(f32x4*)(dst + 4) = acc[ai][bj][m][1]; } } }
        } else {
            if (wc == 0 && fq < 3) {
#pragma unroll
                for (int ai = 0; ai < 2; ++ai)
#pragma unroll
                    for (int m = 0; m < 4; ++m) { const int row = rb + ai * HALF + m * 16; if (row >= NVALID) continue;
                        f32x4 g0, g1;
#pragma unroll
                        for (int e = 0; e < 4; ++e) { g0[e] = fast_sigmoid(acc[ai][0][m][0][e]); g1[e] = fast_sigmoid(acc[ai][0][m][1][e]); }
                        float* dst = GATE + (size_t)row * 32 + 8 * fq; *(f32x4*)dst = g0; *(f32x4*)(dst + 4) = g1; }
            }
        }
    }
};

struct EpiOutProj {
    static constexpr bool PERM = false, AFTER_DRAIN = false;
    const float* x; float* h; bf16_t* hb; const float* g; float* ss;
    __device__ __forceinline__ void operator()(const f32x4 (&acc)[2][2][4][2], const Unit& u, int wr, int wc, int fr, int fq) const {
        const int col0 = u.pn * BM + wc * 32 + 4 * fq;
        f32x4 gv[2][2];
#pragma unroll
        for (int bj = 0; bj < 2; ++bj)
#pragma unroll
            for (int n = 0; n < 2; ++n) gv[bj][n] = *(const f32x4*)(g + col0 + bj * HALF + n * 16);
#pragma unroll
        for (int ai = 0; ai < 2; ++ai)
#pragma unroll
            for (int m = 0; m < 4; ++m) { const int row = u.pm * BM + ai * HALF + wr * 64 + m * 16 + fr; const size_t off = (size_t)row * 1024 + col0; float s = 0.f;
#pragma unroll
                for (int bj = 0; bj < 2; ++bj)
#pragma unroll
                    for (int n = 0; n < 2; ++n) { const f32x4 xv = *(const f32x4*)(x + off + bj * HALF + n * 16); const f32x4 hv = xv + acc[ai][bj][m][n];
                        *(f32x4*)(h + off + bj * HALF + n * 16) = hv; s += (hv[0] * hv[0] + hv[1] * hv[1]) + (hv[2] * hv[2] + hv[3] * hv[3]);
                        const f32x4 hg = hv * gv[bj][n]; unsigned w0 = cvt_pk_bf16(hg[0], hg[1]), w1 = cvt_pk_bf16(hg[2], hg[3]);
                        *(unsigned long long*)(hb + off + bj * HALF + n * 16) = (unsigned long long)w0 | ((unsigned long long)w1 << 32); }
                s += __shfl_xor(s, 16); s += __shfl_xor(s, 32);
                if (fq == 0) atomicAdd(ss + row, s); }
    }
};
struct EpiUp {
    static constexpr bool PERM = true, AFTER_DRAIN = false;
    bf16_t* mid; const float* ss;
    __device__ __forceinline__ void operator()(const f32x4 (&acc)[2][2][4][2], const Unit& u, int wr, int wc, int fr, int fq) const {
        const int col0 = u.pn * BM + wc * 32 + 8 * fq;
#pragma unroll
        for (int ai = 0; ai < 2; ++ai)
#pragma unroll
            for (int m = 0; m < 4; ++m) { const int row = u.pm * BM + ai * HALF + wr * 64 + m * 16 + fr; const float r = __builtin_amdgcn_rsqf(ss[row] * (1.0f / 1024.0f) + 1e-6f);
#pragma unroll
                for (int bj = 0; bj < 2; ++bj) { f32x4 a = acc[ai][bj][m][0] * r, b = acc[ai][bj][m][1] * r;
#pragma unroll
                    for (int e = 0; e < 4; ++e) { const float p = fmaxf(a[e], 0.f), q = fmaxf(b[e], 0.f); a[e] = p * p; b[e] = q * q; }
                    *(u32x4*)(mid + (size_t)row * 4096 + col0 + bj * HALF) = pack8(a, b); } }
    }
};
struct EpiDown {
    static constexpr bool PERM = false, AFTER_DRAIN = false;
    float* h; float* ss;
    __device__ __forceinline__ void operator()(const f32x4 (&acc)[2][2][4][2], const Unit& u, int wr, int wc, int fr, int fq) const {
        const int col0 = u.pn * BM + wc * 32 + 4 * fq;
#pragma unroll
        for (int ai = 0; ai < 2; ++ai)
#pragma unroll
            for (int m = 0; m < 4; ++m) { const int row = u.pm * BM + ai * HALF + wr * 64 + m * 16 + fr; const size_t off = (size_t)row * 1024 + col0; float s = 0.f;
#pragma unroll
                for (int bj = 0; bj < 2; ++bj)
#pragma unroll
                    for (int n = 0; n < 2; ++n) { const f32x4 hv = *(const f32x4*)(h + off + bj * HALF + n * 16) + acc[ai][bj][m][n];
                        *(f32x4*)(h + off + bj * HALF + n * 16) = hv; s += (hv[0] * hv[0] + hv[1] * hv[1]) + (hv[2] * hv[2] + hv[3] * hv[3]); }
                s += __shfl_xor(s, 16); s += __shfl_xor(s, 32);
                if (fq == 0) atomicAdd(ss + row, s); }
    }
};
template <class Epi, class Sched, bool ALIGN_EPI = false, bool SP2 = false>
__device__ __forceinline__ void gemm_phase(PG8_LAS unsigned char* lds, const Gemm g, const Sched& S, const Epi& E) {
    const int tid = threadIdx.x, wid = __builtin_amdgcn_readfirstlane(tid >> 6), lane = tid & 63, wr = wid >> 2, wc = wid & 3, fr = lane & 15, fq = lane >> 4;
    const int K = g.K, nt = K / BK;
    unsigned voffA[2], voffB[2];
#pragma unroll
    for (int i = 0; i < 2; ++i) { int R, C; stage_rc(tid * 16 + i * 8192, R, C); const int Rb = Epi::PERM ? ((R & ~31) + perm32(R & 31)) : R;
        voffA[i] = (unsigned)(R * K + C) * 2u; voffB[i] = (unsigned)(Rb * K + C) * 2u; }
    const size_t kstep = (size_t)(BK * 2);
    const size_t hstep = (size_t)HALF * K * 2;
    const size_t tstep = 2 * hstep;
    const unsigned ldsw = (unsigned)wid * 1024u;
    const int aoff = lds_byte(wr * 64 + fr, fq * 8), boff = lds_byte(wc * 32 + fr, fq * 8);
#define PG8_SA(b, h) (((b) * 2 + (h)) * HTB)
#define PG8_SB(b, h) ((4 + (b) * 2 + (h)) * HTB)
#define PG8_STAGE(bufoff, gbase, voff) do { _Pragma("unroll") for (int _i = 0; _i < 2; ++_i) \
        __builtin_amdgcn_global_load_lds((const unsigned*)((const char*)(gbase) + (voff)[_i]), (PG8_LAS unsigned*)(lds + (bufoff) + ldsw + _i * 8192), 16, 0, 0); } while (0)
#define PG8_LDA(dst, b, h) do { _Pragma("unroll") for (int m = 0; m < 4; ++m) _Pragma("unroll") for (int k = 0; k < 2; ++k) dst[m][k] = *(const PG8_LAS bf16x8*)(lds + PG8_SA(b, h) + aoff + m * 2048 + k * 1024); } while (0)
#define PG8_LDB(dst, b, h) do { _Pragma("unroll") for (int n = 0; n < 2; ++n) _Pragma("unroll") for (int k = 0; k < 2; ++k) dst[n][k] = *(const PG8_LAS bf16x8*)(lds + PG8_SB(b, h) + boff + n * 2048 + k * 1024); } while (0)
#define PG8_MMA(ai, bj, At, Bt) do { __builtin_amdgcn_s_setprio(1); _Pragma("unroll") for (int m = 0; m < 4; ++m) _Pragma("unroll") for (int n = 0; n < 2; ++n) _Pragma("unroll") for (int k = 0; k < 2; ++k) \
        acc[ai][bj][m][n] = __builtin_amdgcn_mfma_f32_16x16x32_bf16(Bt[n][k], At[m][k], acc[ai][bj][m][n], 0, 0, 0); __builtin_amdgcn_s_setprio(0); } while (0)
#define PG8_WAIT_V(n) asm volatile("s_waitcnt vmcnt(" #n ")" ::: "memory")
#define PG8_WAIT_L(n) asm volatile("s_waitcnt lgkmcnt(" #n ")" ::: "memory")
#define PG8_BAR __builtin_amdgcn_s_barrier()
#define PG8_SCHED __builtin_amdgcn_sched_barrier(0)
    Unit cur, nxt; int ui = 0;
    if (!S.next(0, cur)) return;
    f32x4 acc[2][2][4][2];
#pragma unroll
    for (int a = 0; a < 2; ++a)
#pragma unroll
        for (int b = 0; b < 2; ++b)
#pragma unroll
            for (int m = 0; m < 4; ++m)
#pragma unroll
                for (int n = 0; n < 2; ++n) acc[a][b][m][n] = (f32x4){0.f, 0.f, 0.f, 0.f};
    bf16x8 At[4][2], B0[2][2], B1[2][2];
    const char* cA = (const char*)g.A + (size_t)cur.pm * tstep; const char* cB = (const char*)g.Bt + (size_t)cur.pn * tstep;
    S.a_ready(cur);
    if constexpr (SP2) {
        PG8_STAGE(PG8_SB(0, 0), cB, voffB); PG8_STAGE(PG8_SB(0, 1), cB + hstep, voffB); PG8_STAGE(PG8_SA(0, 0), cA, voffA); PG8_STAGE(PG8_SA(0, 1), cA + hstep, voffA);
        if (wr == 1) PG8_BAR;
        PG8_WAIT_V(2); PG8_BAR;
        PG8_STAGE(PG8_SB(1, 0), cB + kstep, voffB); PG8_STAGE(PG8_SA(1, 0), cA + kstep, voffA); PG8_STAGE(PG8_SB(1, 1), cB + hstep + kstep, voffB);
        PG8_WAIT_V(6); PG8_BAR;
    } else {
        PG8_STAGE(PG8_SB(0, 0), cB, voffB); PG8_STAGE(PG8_SA(0, 0), cA, voffA); PG8_STAGE(PG8_SB(0, 1), cB + hstep, voffB); PG8_STAGE(PG8_SA(0, 1), cA + hstep, voffA);
        if (wr == 1) PG8_BAR;
        PG8_WAIT_V(4); PG8_BAR;
        PG8_STAGE(PG8_SB(1, 0), cB + kstep, voffB); PG8_STAGE(PG8_SA(1, 0), cA + kstep, voffA); PG8_STAGE(PG8_SB(1, 1), cB + hstep + kstep, voffB);
        PG8_WAIT_V(6); PG8_BAR;
    }
    for (;;) {
        const bool has_next = S.next(ui + 1, nxt);
        const char* nA = has_next ? (const char*)g.A + (size_t)nxt.pm * tstep : cA; const char* nB = has_next ? (const char*)g.Bt + (size_t)nxt.pn * tstep : cB;
        for (int t = 0; t < nt; t += 2) {
            const bool last = (t == nt - 2);
            const char* a1 = cA + (size_t)(t + 1) * kstep;
            const char* a2 = last ? nA : cA + (size_t)(t + 2) * kstep; const char* b2 = last ? nB : cB + (size_t)(t + 2) * kstep;
            const char* a3 = a2 + kstep; const char* b3 = b2 + kstep;
            if (last && has_next) S.a_ready(nxt);
            if constexpr (SP2) {
            PG8_LDB(B0, 0, 0); PG8_LDB(B1, 0, 1); PG8_SCHED; PG8_LDA(At, 0, 0); PG8_STAGE(PG8_SA(1, 1), a1 + hstep, voffA);
            PG8_WAIT_V(8); PG8_WAIT_L(0); PG8_BAR; PG8_MMA(0, 0, At, B0); PG8_MMA(0, 1, At, B1); PG8_BAR; PG8_SCHED;
            PG8_LDA(At, 0, 1); PG8_STAGE(PG8_SB(0, 0), b2, voffB); PG8_STAGE(PG8_SB(0, 1), b2 + hstep, voffB); PG8_STAGE(PG8_SA(0, 0), a2, voffA);
            PG8_WAIT_V(8); PG8_WAIT_L(0); PG8_BAR; PG8_MMA(1, 0, At, B0); PG8_MMA(1, 1, At, B1); PG8_BAR; PG8_SCHED;
            PG8_LDB(B0, 1, 0); PG8_LDB(B1, 1, 1); PG8_SCHED; PG8_LDA(At, 1, 0); PG8_STAGE(PG8_SA(0, 1), a2 + hstep, voffA);
            PG8_WAIT_V(8); PG8_WAIT_L(0); PG8_BAR; PG8_MMA(0, 0, At, B0); PG8_MMA(0, 1, At, B1); PG8_BAR; PG8_SCHED;
            PG8_LDA(At, 1, 1); PG8_STAGE(PG8_SB(1, 0), b3, voffB); PG8_STAGE(PG8_SB(1, 1), b3 + hstep, voffB); PG8_STAGE(PG8_SA(1, 0), a3, voffA);
            PG8_WAIT_V(8); PG8_WAIT_L(0); PG8_BAR; PG8_MMA(1, 0, At, B0); PG8_MMA(1, 1, At, B1); PG8_BAR; PG8_SCHED;
            } else {
            PG8_LDB(B0, 0, 0); PG8_SCHED; PG8_LDA(At, 0, 0); PG8_STAGE(PG8_SA(1, 1), a1 + hstep, voffA);
            PG8_WAIT_L(8); PG8_BAR; PG8_WAIT_L(0); PG8_MMA(0, 0, At, B0); PG8_BAR; PG8_SCHED;
            PG8_LDB(B1, 0, 1); PG8_STAGE(PG8_SB(0, 0), b2, voffB);
            PG8_BAR; PG8_WAIT_L(0); PG8_MMA(0, 1, At, B1); PG8_BAR;
            PG8_LDA(At, 0, 1); PG8_STAGE(PG8_SA(0, 0), a2, voffA);
            PG8_BAR; PG8_WAIT_L(0); PG8_MMA(1, 0, At, B0); PG8_BAR; PG8_SCHED;
            PG8_STAGE(PG8_SB(0, 1), b2 + hstep, voffB);
            PG8_WAIT_V(6); PG8_BAR; PG8_MMA(1, 1, At, B1); PG8_BAR;
            PG8_LDB(B0, 1, 0); PG8_SCHED; PG8_LDA(At, 1, 0); PG8_STAGE(PG8_SA(0, 1), a2 + hstep, voffA);
            PG8_WAIT_L(8); PG8_BAR; PG8_WAIT_L(0); PG8_MMA(0, 0, At, B0); PG8_BAR; PG8_SCHED;
            PG8_LDB(B1, 1, 1); PG8_STAGE(PG8_SB(1, 0), b3, voffB);
            PG8_BAR; PG8_WAIT_L(0); PG8_MMA(0, 1, At, B1); PG8_BAR;
            PG8_LDA(At, 1, 1); PG8_STAGE(PG8_SA(1, 0), a3, voffA);
            PG8_BAR; PG8_WAIT_L(0); PG8_MMA(1, 0, At, B0); PG8_BAR; PG8_SCHED;
            PG8_STAGE(PG8_SB(1, 1), b3 + hstep, voffB);
            PG8_WAIT_V(6); PG8_BAR; PG8_MMA(1, 1, At, B1); PG8_BAR;
            }
        }
        if constexpr (ALIGN_EPI) { if (wr == 0) PG8_BAR; }
        if constexpr (!Epi::AFTER_DRAIN) { E(acc, cur, wr, wc, fr, fq); S.done(cur); }
        if (!has_next) break;
#pragma unroll
        for (int a = 0; a < 2; ++a)
#pragma unroll
            for (int b = 0; b < 2; ++b)
#pragma unroll
                for (int m = 0; m < 4; ++m)
#pragma unroll
                    for (int n = 0; n < 2; ++n) acc[a][b][m][n] = (f32x4){0.f, 0.f, 0.f, 0.f};
        cur = nxt; cA = nA; cB = nB; ++ui;
        if constexpr (ALIGN_EPI) { if (wr == 1) PG8_BAR; }
    }
    PG8_WAIT_V(0);
    if constexpr (!ALIGN_EPI) { if (wr == 0) PG8_BAR; }
    PG8_BAR;
    if constexpr (Epi::AFTER_DRAIN) { E.fused(acc, cur, wr, wc, fr, fq, lds, wid, lane); S.done(cur); }
#undef PG8_SA
#undef PG8_SB
#undef PG8_STAGE
#undef PG8_LDA
#undef PG8_LDB
#undef PG8_MMA
#undef PG8_WAIT_V
#undef PG8_WAIT_L
#undef PG8_BAR
#undef PG8_SCHED
}
}
#ifndef PG8_SP2
#define PG8_SP2 true
#endif
#ifndef PG8_ALIGN
#define PG8_ALIGN true
#endif

constexpr int NWAVES = 8;
#ifndef MK_N_LAUNCHES
#define MK_N_LAUNCHES 1
#endif
constexpr int N_LAUNCHES = MK_N_LAUNCHES;
constexpr int N_PHASES = 8;

using pg8::MP; using pg8::MS; using pg8::MALL; using pg8::NVALID;
using pg8::O_YP; using pg8::O_YS; using pg8::O_KVP; using pg8::O_WINP; using pg8::O_CONVP; using pg8::O_KVS; using pg8::O_WINS; using pg8::O_CONVS; using pg8::O_END;
constexpr int D = 1024, SEQ = 2048, NB = 8, CC = 512, FF = 4096, NIN = 2328, NINP = 2560, NPHYS = 2560;
constexpr float RMS_EPS = 1e-6f, LN_EPS = 1e-5f;

constexpr size_t MiB = 1u << 20;
constexpr size_t WS_CTL = 0, CTL_ZERO_BYTES = 2 * MiB;
constexpr size_t WS_SS1 = 256 * 1024, WS_SS2 = 384 * 1024, WS_DACC = 1 * MiB;
constexpr size_t WS_WIN = 2 * MiB, WS_WOUT = 7 * MiB, WS_WUP = 9 * MiB, WS_WDN = 17 * MiB;
constexpr size_t WS_XN = 26 * MiB, WS_G = 59 * MiB, WS_Q = 76 * MiB, WS_KV = 93 * MiB, WS_GATE = 118 * MiB;
constexpr size_t WS_KCP = 121 * MiB, WS_VCP = 121 * MiB + 256 * 1024, WS_KCVS = 122 * MiB;
constexpr size_t WS_AO = 130 * MiB, WS_HB = 163 * MiB, WS_MID = 196 * MiB, WS_END = 327 * MiB;
static_assert(WS_XN + (size_t)MALL * D * 2 <= WS_G && WS_G + (size_t)MALL * CC * 2 <= WS_Q && WS_Q + (size_t)MALL * 512 * 2 <= WS_KV && WS_KV + (size_t)MALL * 768 * 2 <= WS_GATE &&
              WS_GATE + (size_t)MALL * 32 * 4 <= WS_KCP && WS_KCVS + (size_t)MS * 64 * 256 * 4 <= WS_AO && WS_AO + (size_t)MALL * D * 2 <= WS_HB && WS_HB + (size_t)MALL * D * 2 <= WS_MID &&
              WS_MID + (size_t)MALL * FF * 2 <= WS_END, "d_ws map");
constexpr int CW_TMO = 0, CW_QUEUE = 64;
constexpr int CW_BAR = 4096;

constexpr int RING_OFF = 0, RING_BYTES = 131072;
constexpr int LDSCTL_OFF = RING_BYTES, MISC_OFF = LDSCTL_OFF + 320;
constexpr int LDS_BYTES = 147456;

#define GAS __attribute__((address_space(1)))
#define LAS __attribute__((address_space(3)))
typedef unsigned short bf16;
typedef unsigned v4u __attribute__((ext_vector_type(4)));
typedef float f32x4 __attribute__((ext_vector_type(4)));
typedef short bf16x8 __attribute__((ext_vector_type(8)));
typedef GAS unsigned gu32;
typedef GAS unsigned long long gu64;
#define RLX_AGENT __ATOMIC_RELAXED, __HIP_MEMORY_SCOPE_AGENT
#define LDS_WAIT() asm volatile("s_waitcnt lgkmcnt(0)" ::: "memory")
#define VM_WAIT() asm volatile("s_waitcnt vmcnt(0)" ::: "memory")
__device__ __forceinline__ unsigned long long rt() { return __builtin_amdgcn_s_memrealtime(); }
__device__ __forceinline__ unsigned f2bf(float f) { unsigned u = __builtin_bit_cast(unsigned, f); return (u + 0x7fffu + ((u >> 16) & 1u)) >> 16; }
__device__ __forceinline__ unsigned pk2(float lo, float hi) { return f2bf(lo) | (f2bf(hi) << 16); }

#define XB_TMO      128
#define XB_XCNT(j)  (256  + 64 * (j))
#define XB_XSUB(j)  (1280 + 64 * (j))
#define XB_XGEN(j)  (2304 + 64 * (j))
#define XB_TOP      3328
#define XB_TOPGEN   3392
#define XCD_BAR_WORDS 3456
#define XB_SPIN_CAP (1u << 18)

__device__ __forceinline__ unsigned xb_ld(unsigned* p)              { return __hip_atomic_load(p, __ATOMIC_RELAXED, __HIP_MEMORY_SCOPE_AGENT); }
__device__ __forceinline__ unsigned xb_add(unsigned* p, unsigned v) { return __hip_atomic_fetch_add(p, v, __ATOMIC_RELAXED, __HIP_MEMORY_SCOPE_AGENT); }
__device__ __forceinline__ unsigned xb_xcc_id() { return (unsigned)__builtin_amdgcn_s_getreg((3 << 11) | 20) & 0xFu; }
#define XB_SPIN(cond, bar) do { unsigned _sp = 0; while (cond) { __builtin_amdgcn_s_sleep(1); \
    if ((++_sp & 255u) == 0u) { if (xb_ld(&(bar)[XB_TMO])) break; if (_sp > XB_SPIN_CAP) { atomicAdd(&(bar)[XB_TMO], 1u); break; } } } } while (0)

struct XcdBarrier {
    unsigned* bar; unsigned x;
    volatile LAS unsigned* st;
};

__device__ __forceinline__ XcdBarrier xcd_barrier_post(unsigned* bar, volatile LAS unsigned* st) {
    XcdBarrier b; b.bar = bar; b.x = xb_xcc_id(); b.st = st;
    if (threadIdx.x == 0) (void)xb_add(&bar[XB_XCNT(b.x)], 1u);
    return b;
}
__device__ __forceinline__ void xcd_barrier_complete(unsigned* bar, unsigned x, unsigned& nloc, unsigned& nx) {
    const unsigned G = gridDim.x * gridDim.y * gridDim.z;
    unsigned sum, cnt, mine, sp = 0u;
    for (;;) {
        sum = 0u; cnt = 0u; mine = 0u;
#pragma unroll
        for (unsigned j = 0; j < 16; ++j) { const unsigned c = xb_ld(&bar[XB_XCNT(j)]); sum += c; cnt += (c > 0u) ? 1u : 0u; mine = (j == x) ? c : mine; }
        if (sum == G) break;
        __builtin_amdgcn_s_sleep(1);
        if ((++sp & 255u) == 0u) { if (xb_ld(&bar[XB_TMO])) break; if (sp > XB_SPIN_CAP) { atomicAdd(&bar[XB_TMO], 1u); break; } }
    }
    nloc = mine > 0u ? mine : 1u; nx = cnt > 0u ? cnt : 1u;
}

__device__ __forceinline__ void xcd_barrier(const XcdBarrier& b) {
    asm volatile("s_waitcnt vmcnt(0)" ::: "memory");
    __syncthreads();
    if (threadIdx.x == 0) {
        unsigned* bar = b.bar;
        __builtin_amdgcn_s_waitcnt(0);
        unsigned nloc = b.st[0], nx = b.st[1];
        if (nloc == 0u) { xcd_barrier_complete(bar, b.x, nloc, nx); b.st[0] = nloc; b.st[1] = nx; }
        const unsigned old = xb_add(&bar[XB_XSUB(b.x)], 1u);
        const unsigned gen = old / nloc;
        if (old + 1u == (gen + 1u) * nloc) {
            __builtin_amdgcn_fence(__ATOMIC_RELEASE, "agent");
            asm volatile("s_waitcnt vmcnt(0)" ::: "memory");
            const unsigned og = xb_add(&bar[XB_TOP], 1u);
            const unsigned tg = og / nx;
            if (og + 1u == (tg + 1u) * nx) xb_add(&bar[XB_TOPGEN], 1u);
            else XB_SPIN(xb_ld(&bar[XB_TOPGEN]) == tg, bar);
            __builtin_amdgcn_fence(__ATOMIC_ACQUIRE, "agent");
            xb_add(&bar[XB_XGEN(b.x)], 1u);
            asm volatile("s_waitcnt vmcnt(0)" ::: "memory");
        } else {
            XB_SPIN(xb_ld(&bar[XB_XGEN(b.x)]) == gen, bar);
            __builtin_amdgcn_fence(__ATOMIC_ACQUIRE, "agent");
            asm volatile("s_waitcnt vmcnt(0)" ::: "memory");
        }
    }
    __syncthreads();
}

typedef const __attribute__((address_space(4))) unsigned char* kptr_t;
struct Frame {
    LAS unsigned char* lds;
    volatile LAS unsigned* MISC;
    kptr_t ka;
    gu32* ctl;
    int tid, lane, wave;
    int vcu, G;
    const float *x_prompt, *x_sample, *cache_kv, *cache_win, *state_conv; const int* page_table;
    const float *g_attn, *w_in, *w_dw, *b_dw, *ln_g, *ln_b, *w_ck, *w_cv, *w_out, *g_mlp, *w_up, *w_down, *g_final;
    float* out;
    bf16 *Win_t, *Wout_t, *Wup_t, *Wdn_t, *XN, *Gb, *Qb, *KVb, *KCP, *VCP, *AO, *HB, *MID;
    float *GATE, *KCVS, *SS1, *SS2, *DACC;
};

__device__ __forceinline__ void frame_fill(Frame& F) {
    kptr_t ka = F.ka; asm volatile("" : "+s"(ka));
    typedef const void* const __attribute__((address_space(4)))* kpp_t;
    kpp_t in = (kpp_t)ka;
    F.x_prompt = (const float*)in[0]; F.x_sample = (const float*)in[1]; F.cache_kv = (const float*)in[2]; F.cache_win = (const float*)in[3];
    F.state_conv = (const float*)in[4]; F.page_table = (const int*)in[5]; F.g_attn = (const float*)in[6]; F.w_in = (const float*)in[7];
    F.w_dw = (const float*)in[8]; F.b_dw = (const float*)in[9]; F.ln_g = (const float*)in[10]; F.ln_b = (const float*)in[11];
    F.w_ck = (const float*)in[12]; F.w_cv = (const float*)in[13]; F.w_out = (const float*)in[14]; F.g_mlp = (const float*)in[15];
    F.w_up = (const float*)in[16]; F.w_down = (const float*)in[17]; F.g_final = (const float*)in[18];
    F.out = (float*)in[19];
    unsigned char* ws = (unsigned char*)in[20];
    F.ctl = (gu32*)(ws + WS_CTL);
    F.Win_t = (bf16*)(ws + WS_WIN); F.Wout_t = (bf16*)(ws + WS_WOUT); F.Wup_t = (bf16*)(ws + WS_WUP); F.Wdn_t = (bf16*)(ws + WS_WDN);
    F.XN = (bf16*)(ws + WS_XN); F.Gb = (bf16*)(ws + WS_G); F.Qb = (bf16*)(ws + WS_Q); F.KVb = (bf16*)(ws + WS_KV); F.GATE = (float*)(ws + WS_GATE);
    F.KCP = (bf16*)(ws + WS_KCP); F.VCP = (bf16*)(ws + WS_VCP); F.KCVS = (float*)(ws + WS_KCVS);
    F.AO = (bf16*)(ws + WS_AO); F.HB = (bf16*)(ws + WS_HB); F.MID = (bf16*)(ws + WS_MID);
    F.SS1 = (float*)(ws + WS_SS1); F.SS2 = (float*)(ws + WS_SS2); F.DACC = (float*)(ws + WS_DACC);
}
__device__ __forceinline__ float wave_sum(float v) {
#pragma unroll
    for (int o = 1; o < 64; o <<= 1) v += __shfl_xor(v, o);
    return v;
}
__device__ __forceinline__ float sigmoidf_(float x) { return __builtin_amdgcn_rcpf(1.0f + __builtin_amdgcn_exp2f(-1.4426950408889634f * x)); }
__device__ __forceinline__ float bf2f(unsigned short b) { return __uint_as_float((unsigned)b << 16); }

__device__ __forceinline__ void p0_transpose_item(const float* W, int K, int N, bf16* WT, int k0, int n0, int drow0, LAS float* scr, int lane) {
#pragma unroll 8
    for (int i = 0; i < 32; ++i) { const int kk = 2 * i + (lane >> 5); const int n = n0 + (lane & 31); scr[kk * 33 + (lane & 31)] = (n < N) ? W[(size_t)(k0 + kk) * N + n] : 0.f; }
    LDS_WAIT(); asm volatile("" ::: "memory");
    const int c = lane & 7;
#pragma unroll
    for (int j = 0; j < 4; ++j) { const int n = (lane >> 3) + 8 * j; const LAS float* s = scr + (8 * c) * 33 + n;
        v4u o; o.x = pk2(s[0 * 33], s[1 * 33]); o.y = pk2(s[2 * 33], s[3 * 33]); o.z = pk2(s[4 * 33], s[5 * 33]); o.w = pk2(s[6 * 33], s[7 * 33]);
        *(GAS v4u*)(WT + (size_t)(drow0 + n) * K + k0 + 8 * c) = o; }
    LDS_WAIT(); asm volatile("" ::: "memory");
}
__device__ __forceinline__ int win_row(int n) { if (n < 512) return 256 * (n >> 7) + (n & 127); if (n < 1024) { const int c = n - 512; return 256 * (c >> 7) + 128 + (c & 127); } return n; }

__device__ __forceinline__ void rms_row_to_bf16(const float* xrow, const float* g, bf16* orow, int lane) {
    const GAS f32x4* xr = (const GAS f32x4*)xrow + lane; const GAS f32x4* gr = (const GAS f32x4*)g + lane;
    f32x4 v[4]; float s = 0.f;
#pragma unroll
    for (int j = 0; j < 4; ++j) { v[j] = xr[64 * j]; s += (v[j].x * v[j].x + v[j].y * v[j].y) + (v[j].z * v[j].z + v[j].w * v[j].w); }
    const float r = 1.0f / sqrtf(wave_sum(s) * (1.f / 1024.f) + RMS_EPS);
    GAS unsigned long long* o8 = (GAS unsigned long long*)orow + lane;
#pragma unroll
    for (int j = 0; j < 4; ++j) { const f32x4 gg = gr[64 * j]; o8[64 * j] = (unsigned long long)pk2(v[j].x * r * gg.x, v[j].y * r * gg.y) | ((unsigned long long)pk2(v[j].z * r * gg.z, v[j].w * r * gg.w) << 32); }
}
__device__ __forceinline__ void spool_item(Frame& F, int item) {
    const int bs = item >> 6, c = item & 63, lane = F.lane;
    const int page = F.page_table[bs * 16 + (c >> 2)], row0 = (c & 3) * 32;
    const float* src = F.cache_kv + ((size_t)page * 128 + row0) * 512 + lane * 4;
    const float* w = (lane < 32 ? F.w_ck : F.w_cv) + ((lane >> 4) & 1);
    f32x4 acc = (f32x4){0.f, 0.f, 0.f, 0.f};
#pragma unroll
    for (int hlf = 0; hlf < 2; ++hlf) {
        f32x4 v[16]; float wj[16];
#pragma unroll
        for (int j = 0; j < 16; ++j) { v[j] = __builtin_nontemporal_load((const f32x4*)(src + (size_t)(hlf * 16 + j) * 512)); wj[j] = w[(hlf * 16 + j) * 2]; }
#pragma unroll
        for (int j = 0; j < 16; ++j) acc += v[j] * wj[j];
    }
    *(f32x4*)(F.KCVS + ((size_t)bs * 64 + c) * 256 + lane * 4) = acc;
}
__device__ __forceinline__ void p0_prologue(Frame& F) {
    LAS float* scr = (LAS float*)(F.lds + RING_OFF + F.wave * 16384);
    const int gw = F.vcu * NWAVES + F.wave, NGW = F.G * NWAVES;
    constexpr int NB_IN = 73;
    constexpr int I_IN = (D / 64) * NB_IN, I_OUT = (D / 64) * (D / 32), I_UP = (D / 64) * (FF / 32), I_DN = (FF / 64) * (D / 32);
    constexpr int NITEMS = I_IN + I_OUT + I_UP + I_DN;
    for (int it = gw; it < NITEMS; it += NGW) {
        int r = it;
        if (r < I_IN) { const int kb = r / NB_IN, nb = r % NB_IN; p0_transpose_item(F.w_in, D, NIN, F.Win_t, 64 * kb, 32 * nb, win_row(32 * nb), scr, F.lane); continue; } r -= I_IN;
        if (r < I_OUT) { const int kb = r / (D / 32), nb = r % (D / 32); p0_transpose_item(F.w_out, D, D, F.Wout_t, 64 * kb, 32 * nb, 32 * nb, scr, F.lane); continue; } r -= I_OUT;
        if (r < I_UP) { const int kb = r / (FF / 32), nb = r % (FF / 32); p0_transpose_item(F.w_up, D, FF, F.Wup_t, 64 * kb, 32 * nb, 32 * nb, scr, F.lane); continue; } r -= I_UP;
        { const int kb = r / (D / 32), nb = r % (D / 32); p0_transpose_item(F.w_down, FF, D, F.Wdn_t, 64 * kb, 32 * nb, 32 * nb, scr, F.lane); }
    }
    for (int rr = gw; rr < NINP - 2336; rr += NGW) { GAS v4u* o = (GAS v4u*)(F.Win_t + (size_t)(2336 + rr) * D) + F.lane; o[0] = (v4u){0u, 0u, 0u, 0u}; o[64] = (v4u){0u, 0u, 0u, 0u}; }
    for (int m = gw; m < MALL; m += NGW) {
        if (m < MP) rms_row_to_bf16(F.x_prompt + (size_t)m * D, F.g_attn, F.XN + (size_t)m * D, F.lane);
        else if (m < NVALID) rms_row_to_bf16(F.x_sample + (size_t)(m - MP) * D, F.g_attn, F.XN + (size_t)m * D, F.lane);
        else { GAS v4u* o = (GAS v4u*)(F.XN + (size_t)m * D) + F.lane; o[0] = (v4u){0u, 0u, 0u, 0u}; o[64] = (v4u){0u, 0u, 0u, 0u}; }
    }
    for (int it = gw; it < MS * 64; it += NGW) spool_item(F, it);
}

__device__ __forceinline__ void conv_unit(Frame& F, int unit) {
    const int b = unit >> 6, t0 = (unit & 63) * 32, tg = F.wave >> 2, cq = F.wave & 3, lane = F.lane;
    const int ch = cq * 128 + 2 * lane, tbase = t0 + 16 * tg;
    float w0[31], w1[31];
#pragma unroll
    for (int j = 0; j < 31; ++j) { const float2 wv = *(const float2*)(F.w_dw + j * 512 + ch); w0[j] = wv.x; w1[j] = wv.y; }
    unsigned xr[46];
#pragma unroll
    for (int r = 0; r < 46; ++r) { const int tr = tbase - 30 + r; xr[r] = (tr >= 0) ? *(const unsigned*)(F.Gb + ((size_t)(b * SEQ + tr)) * 512 + ch) : 0u; }
    const float2 bd = *(const float2*)(F.b_dw + ch);
    float a0[16], a1[16];
#pragma unroll
    for (int i = 0; i < 16; ++i) { a0[i] = bd.x; a1[i] = bd.y; }
#pragma unroll
    for (int r = 0; r < 46; ++r) { const float x0 = __uint_as_float(xr[r] << 16), x1 = __uint_as_float(xr[r] & 0xffff0000u);
#pragma unroll
        for (int i = 0; i < 16; ++i) { const int j = r - i; if (j >= 0 && j <= 30) { a0[i] += x0 * w0[j]; a1[i] += x1 * w1[j]; } } }
    typedef float f32x2v __attribute__((ext_vector_type(2)));
    LAS f32x2v* RED = (LAS f32x2v*)(F.lds + RING_OFF);
    LAS f32x2v* STAT = (LAS f32x2v*)(F.lds + RING_OFF + 65536);
#pragma unroll
    for (int i = 0; i < 16; ++i) RED[(tg * 16 + i) * 256 + cq * 64 + lane] = (f32x2v){a0[i] + a1[i], a0[i] * a0[i] + a1[i] * a1[i]};
    __syncthreads();
    { const int tk = F.tid >> 4, p = F.tid & 15; float s = 0.f, q = 0.f;
#pragma unroll
      for (int e = 0; e < 16; ++e) { const f32x2v v = RED[tk * 256 + p * 16 + e]; s += v.x; q += v.y; }
#pragma unroll
      for (int o = 1; o < 16; o <<= 1) { s += __shfl_xor(s, o); q += __shfl_xor(q, o); }
      if (p == 0) { const float mu = s * (1.f / 512.f); const float var = fmaxf(q * (1.f / 512.f) - mu * mu, 0.f); STAT[tk] = (f32x2v){mu, 1.0f / sqrtf(var + LN_EPS)}; } }
    __syncthreads();
    const float2 lg = *(const float2*)(F.ln_g + ch), lb = *(const float2*)(F.ln_b + ch);
#pragma unroll
    for (int i = 0; i < 16; ++i) { const f32x2v st = STAT[tg * 16 + i];
        const float y0 = (a0[i] - st.x) * st.y * lg.x + lb.x, y1 = (a1[i] - st.x) * st.y * lg.y + lb.y;
        *(unsigned*)(F.AO + ((size_t)(b * SEQ + tbase + i)) * D + ch) = pk2(y0 * sigmoidf_(y0), y1 * sigmoidf_(y1)); }
    __syncthreads();
}
__device__ __forceinline__ void sconv_item(Frame& F, int bs) {
    const int lane = F.lane, c = lane * 8;
    const float* st = F.state_conv + (size_t)bs * 30 * 512 + c;
    float* oc = F.out + O_CONVS + (size_t)bs * 30 * 512 + c;
    f32x4 a0 = *(const f32x4*)(F.b_dw + c), a1 = *(const f32x4*)(F.b_dw + c + 4);
#pragma unroll 6
    for (int j = 0; j < 30; ++j) { const f32x4 s0 = *(const f32x4*)(st + j * 512), s1 = *(const f32x4*)(st + j * 512 + 4);
        const f32x4 w0 = *(const f32x4*)(F.w_dw + j * 512 + c), w1 = *(const f32x4*)(F.w_dw + j * 512 + c + 4);
        a0 += s0 * w0; a1 += s1 * w1;
        if (j >= 1) { *(f32x4*)(oc + (j - 1) * 512) = s0; *(f32x4*)(oc + (j - 1) * 512 + 4) = s1; } }
    { const f32x4 s0 = *(const f32x4*)(oc + 29 * 512), s1 = *(const f32x4*)(oc + 29 * 512 + 4);
      const f32x4 w0 = *(const f32x4*)(F.w_dw + 30 * 512 + c), w1 = *(const f32x4*)(F.w_dw + 30 * 512 + c + 4); a0 += s0 * w0; a1 += s1 * w1; }
    float s = (a0[0] + a0[1]) + (a0[2] + a0[3]) + (a1[0] + a1[1]) + (a1[2] + a1[3]);
    const float mu = wave_sum(s) * (1.f / 512.f);
    a0 = a0 - mu; a1 = a1 - mu;
    float q = (a0[0] * a0[0] + a0[1] * a0[1]) + (a0[2] * a0[2] + a0[3] * a0[3]) + (a1[0] * a1[0] + a1[1] * a1[1]) + (a1[2] * a1[2] + a1[3] * a1[3]);
    const float rstd = 1.0f / sqrtf(wave_sum(q) * (1.f / 512.f) + LN_EPS);
    const f32x4 g0 = *(const f32x4*)(F.ln_g + c), g1 = *(const f32x4*)(F.ln_g + c + 4), b0 = *(const f32x4*)(F.ln_b + c), b1 = *(const f32x4*)(F.ln_b + c + 4);
    f32x4 y0 = a0 * rstd * g0 + b0, y1 = a1 * rstd * g1 + b1;
#pragma unroll
    for (int e = 0; e < 4; ++e) { y0[e] *= sigmoidf_(y0[e]); y1[e] *= sigmoidf_(y1[e]); }
    v4u o; o.x = pk2(y0[0], y0[1]); o.y = pk2(y0[2], y0[3]); o.z = pk2(y1[0], y1[1]); o.w = pk2(y1[2], y1[3]);
    *(GAS v4u*)(F.AO + (size_t)(MP + bs) * D + c) = o;
}
__device__ __forceinline__ void ppool_item(Frame& F, int item) {
    const int b = item >> 6, c = item & 63, lane = F.lane;
    const bf16* src = F.KVb + ((size_t)(b * SEQ + c * 32)) * 768 + lane * 4;
    const float* w = (lane < 32 ? F.w_ck : F.w_cv) + ((lane >> 4) & 1);
    float a[4] = {0.f, 0.f, 0.f, 0.f};
#pragma unroll 8
    for (int j = 0; j < 32; ++j) { const unsigned long long v = *(const unsigned long long*)(src + (size_t)j * 768); const float wj = w[j * 2];
        a[0] += bf2f((unsigned short)v) * wj; a[1] += bf2f((unsigned short)(v >> 16)) * wj; a[2] += bf2f((unsigned short)(v >> 32)) * wj; a[3] += bf2f((unsigned short)(v >> 48)) * wj; }
    const int h = (lane >> 4) & 1, d = (lane & 15) * 4;
    bf16* dst = (lane < 32 ? F.KCP : F.VCP) + ((size_t)((b * 2 + h) * 64 + c)) * 64 + d;
    *(unsigned long long*)dst = (unsigned long long)pk2(a[0], a[1]) | ((unsigned long long)pk2(a[2], a[3]) << 32);
}
__device__ __forceinline__ void p2_phase(Frame& F) {
    const int gw = F.vcu * NWAVES + F.wave, NGW = F.G * NWAVES;
    for (int it = gw; it < NB * 64; it += NGW) ppool_item(F, it);
    for (int it = gw; it < MS; it += NGW) sconv_item(F, it);
    for (int u = F.vcu; u < MP / 32; u += F.G) conv_unit(F, u);
}

__device__ __forceinline__ pg8::f32x4 skinny_tile(const bf16* A, int lda, const bf16* Bt, int ldb, int n0, int k0, int klen, int wave, int lane) {
    const bf16* ap = A + (size_t)(16 * wave + (lane & 15)) * lda + k0 + 8 * (lane >> 4);
    const bf16* bp = Bt + (size_t)(n0 + (lane & 15)) * ldb + k0 + 8 * (lane >> 4);
    pg8::f32x4 acc = (pg8::f32x4){0.f, 0.f, 0.f, 0.f};
    for (int kk = 0; kk < klen; kk += 256) {
        bf16x8 a[8], b[8];
#pragma unroll
        for (int s = 0; s < 8; ++s) { a[s] = *(const bf16x8*)(ap + kk + s * 32); b[s] = *(const bf16x8*)(bp + kk + s * 32); }
#pragma unroll
        for (int s = 0; s < 8; ++s) acc = __builtin_amdgcn_mfma_f32_16x16x32_bf16(a[s], b[s], acc, 0, 0, 0);
    }
    return acc;
}
__device__ __forceinline__ void s_outproj_item(Frame& F, int item) {
    const int n0 = item * 16, lane = F.lane, col = n0 + (lane & 15);
    const pg8::f32x4 acc = skinny_tile(F.AO + (size_t)MP * D, D, F.Wout_t, D, n0, 0, D, F.wave, lane);
    const float g = F.g_mlp[col];
#pragma unroll
    for (int i = 0; i < 4; ++i) { const int row = 16 * F.wave + 4 * (lane >> 4) + i; const float hv = F.x_sample[(size_t)row * D + col] + acc[i];
        F.out[O_YS + (size_t)row * D + col] = hv; F.HB[(size_t)(MP + row) * D + col] = (bf16)f2bf(hv * g);
        float s = hv * hv; s += __shfl_xor(s, 1); s += __shfl_xor(s, 2); s += __shfl_xor(s, 4); s += __shfl_xor(s, 8);
        if ((lane & 15) == 0) atomicAdd(F.SS1 + MP + row, s); }
}
__device__ __forceinline__ void s_up_item(Frame& F, int item) {
    const int n0 = item * 16, lane = F.lane, col = n0 + (lane & 15);
    const pg8::f32x4 acc = skinny_tile(F.HB + (size_t)MP * D, D, F.Wup_t, D, n0, 0, D, F.wave, lane);
#pragma unroll
    for (int i = 0; i < 4; ++i) { const int row = 16 * F.wave + 4 * (lane >> 4) + i; const float r = __builtin_amdgcn_rsqf(F.SS1[MP + row] * (1.f / 1024.f) + RMS_EPS);
        const float v = fmaxf(acc[i] * r, 0.f); F.MID[(size_t)(MP + row) * FF + col] = (bf16)f2bf(v * v); }
}
__device__ __forceinline__ void s_down_item(Frame& F, int item) {
    const int n0 = (item & 63) * 16, kq = item >> 6, lane = F.lane, col = n0 + (lane & 15);
    const pg8::f32x4 acc = skinny_tile(F.MID + (size_t)MP * FF, FF, F.Wdn_t, FF, n0, kq * 1024, 1024, F.wave, lane);
#pragma unroll
    for (int i = 0; i < 4; ++i) { const int row = 16 * F.wave + 4 * (lane >> 4) + i; atomicAdd(F.DACC + (size_t)row * D + col, acc[i]); }
}
__device__ __forceinline__ void p7_phase(Frame& F) {
    const int gw = F.vcu * NWAVES + F.wave, NGW = F.G * NWAVES, lane = F.lane;
    const GAS f32x4* gr = (const GAS f32x4*)F.g_final + lane;
    f32x4 gg[4];
#pragma unroll
    for (int j = 0; j < 4; ++j) gg[j] = gr[64 * j];
    for (int m = gw; m < MS; m += NGW) {
        GAS f32x4* yr = (GAS f32x4*)(F.out + O_YS + (size_t)m * D) + lane; const GAS f32x4* dr = (const GAS f32x4*)(F.DACC + (size_t)m * D) + lane;
        f32x4 v[4]; float s = 0.f;
#pragma unroll
        for (int j = 0; j < 4; ++j) { v[j] = yr[64 * j] + dr[64 * j]; s += (v[j].x * v[j].x + v[j].y * v[j].y) + (v[j].z * v[j].z + v[j].w * v[j].w); }
        const float r = 1.0f / sqrtf(wave_sum(s) * (1.f / 1024.f) + RMS_EPS);
#pragma unroll
        for (int j = 0; j < 4; ++j) yr[64 * j] = v[j] * r * gg[j];
    }
    for (int m = gw; m < MP; m += NGW) {
        GAS f32x4* yr = (GAS f32x4*)(F.out + O_YP + (size_t)m * D) + lane;
        const float r = 1.0f / sqrtf(F.SS2[m] * (1.f / 1024.f) + RMS_EPS);
        f32x4 v[4];
#pragma unroll
        for (int j = 0; j < 4; ++j) v[j] = yr[64 * j];
#pragma unroll
        for (int j = 0; j < 4; ++j) yr[64 * j] = v[j] * r * gg[j];
    }
}

namespace att {
typedef short bf16x8 __attribute__((ext_vector_type(8)));
typedef short s16x4 __attribute__((ext_vector_type(4)));
typedef float f32x16 __attribute__((ext_vector_type(16)));
typedef unsigned u32x4 __attribute__((ext_vector_type(4)));
typedef float f32x2_t __attribute__((ext_vector_type(2))); typedef __bf16 bf16x2_t __attribute__((ext_vector_type(2)));
#define ALAS __attribute__((address_space(3)))
constexpr int A_K = 0, A_V = 16384, A_WS = 32768, A_PBLK = 34816, A_SELM = 43264, A_OST = 43520, A_QSLOT = 109056, A_BON = 109120, A_END = 109248;
constexpr int S_SC = 0, S_PH = 1024, S_PBL = 2048, S_SEL = 2304, S_ML = 2560, S_MO = 3072, S_RES = 11264, S_END = 14336;
constexpr float NEGINF = -INFINITY, MINIT = -1e30f, THR = 8.0f;

__device__ __forceinline__ int crow(int r, int hi) { return (r & 3) + 8 * (r >> 2) + 4 * hi; }
__device__ __forceinline__ unsigned cvtpk_s(float lo, float hi) { f32x2_t v = {lo, hi}; bf16x2_t b = __builtin_convertvector(v, bf16x2_t); return __builtin_bit_cast(unsigned, b); }
__device__ __forceinline__ float sum_halves(float v) { auto rr = __builtin_amdgcn_permlane32_swap(__float_as_uint(v), __float_as_uint(v), false, false); return __uint_as_float(rr[0]) + __uint_as_float(rr[1]); }

__device__ __forceinline__ void qk_tile(f32x16& p0, f32x16& p1, const ALAS char* kslot, const bf16x8 (&qr)[4], int r32, int hi) {
    const ALAS char* kb = kslot + hi * 1024 + r32 * 16;
    p0 = (f32x16){}; p1 = (f32x16){};
#pragma unroll
    for (int d0 = 0; d0 < 4; ++d0) {
        const bf16x8 b0 = *(const ALAS bf16x8*)(kb + d0 * 2048), b1 = *(const ALAS bf16x8*)(kb + d0 * 2048 + 512);
        p0 = __builtin_amdgcn_mfma_f32_32x32x16_bf16(b0, qr[d0], p0, 0, 0, 0); p1 = __builtin_amdgcn_mfma_f32_32x32x16_bf16(b1, qr[d0], p1, 0, 0, 0); }
}
__device__ __forceinline__ void pv_tile(f32x16 (&o)[2], unsigned vb, bf16x8 pa0, bf16x8 pa1, bf16x8 pa2, bf16x8 pa3) {
#pragma unroll
    for (int d0 = 0; d0 < 2; ++d0) { s16x4 lo[4], hi[4];
#pragma unroll
        for (int ks = 0; ks < 4; ++ks) {
            asm volatile("ds_read_b64_tr_b16 %0,%1 offset:%c2" : "=&v"(lo[ks]) : "v"(vb), "i"(d0 * 4096 + ks * 1024) : "memory");
            asm volatile("ds_read_b64_tr_b16 %0,%1 offset:%c2" : "=&v"(hi[ks]) : "v"(vb), "i"(d0 * 4096 + ks * 1024 + 512) : "memory"); }
        asm volatile("s_waitcnt lgkmcnt(0)" ::: "memory"); __builtin_amdgcn_sched_barrier(0);
#define ATT_PK(k) (bf16x8){lo[k][0], lo[k][1], lo[k][2], lo[k][3], hi[k][0], hi[k][1], hi[k][2], hi[k][3]}
        o[d0] = __builtin_amdgcn_mfma_f32_32x32x16_bf16(pa0, ATT_PK(0), o[d0], 0, 0, 0);
        o[d0] = __builtin_amdgcn_mfma_f32_32x32x16_bf16(pa1, ATT_PK(1), o[d0], 0, 0, 0);
        o[d0] = __builtin_amdgcn_mfma_f32_32x32x16_bf16(pa2, ATT_PK(2), o[d0], 0, 0, 0);
        o[d0] = __builtin_amdgcn_mfma_f32_32x32x16_bf16(pa3, ATT_PK(3), o[d0], 0, 0, 0);
#undef ATT_PK
    }
}
__device__ __forceinline__ float rowmax32(const f32x16& p0, const f32x16& p1) {
    float a = fmaxf(p0[0], p1[0]);
#pragma unroll
    for (int r = 1; r < 16; ++r) a = fmaxf(a, fmaxf(p0[r], p1[r]));
    auto rr = __builtin_amdgcn_permlane32_swap(__float_as_uint(a), __float_as_uint(a), false, false);
    return fmaxf(__uint_as_float(rr[0]), __uint_as_float(rr[1]));
}
struct SoftState { float m, l; };
__device__ __forceinline__ void softmax_step(f32x16& p0, f32x16& p1, SoftState& st, f32x16 (&o)[2], ALAS float* wsf, int r32, int hi) {
    const float rm = rowmax32(p0, p1);
    if (__any(rm > st.m + THR)) {
        const float mn = fmaxf(st.m, rm); const float alpha = __builtin_amdgcn_exp2f(st.m - mn); st.m = mn; st.l *= alpha;
        if (hi == 0) wsf[r32] = alpha;
        asm volatile("s_waitcnt lgkmcnt(0)" ::: "memory");
#pragma unroll
        for (int r = 0; r < 16; ++r) { const float f = wsf[crow(r, hi)]; o[0][r] *= f; o[1][r] *= f; }
    }
    float s = 0.f;
#pragma unroll
    for (int r = 0; r < 16; ++r) { p0[r] = __builtin_amdgcn_exp2f(p0[r] - st.m); p1[r] = __builtin_amdgcn_exp2f(p1[r] - st.m); s += p0[r] + p1[r]; }
    st.l += s;
}
__device__ __forceinline__ void pv_from_p(f32x16 (&o)[2], const f32x16& p0, const f32x16& p1, unsigned vb) {
    u32x4 w0, w1, w2, w3;
    w0 = (u32x4){cvtpk_s(p0[0], p0[1]), cvtpk_s(p0[2], p0[3]), cvtpk_s(p0[4], p0[5]), cvtpk_s(p0[6], p0[7])};
    w1 = (u32x4){cvtpk_s(p0[8], p0[9]), cvtpk_s(p0[10], p0[11]), cvtpk_s(p0[12], p0[13]), cvtpk_s(p0[14], p0[15])};
    w2 = (u32x4){cvtpk_s(p1[0], p1[1]), cvtpk_s(p1[2], p1[3]), cvtpk_s(p1[4], p1[5]), cvtpk_s(p1[6], p1[7])};
    w3 = (u32x4){cvtpk_s(p1[8], p1[9]), cvtpk_s(p1[10], p1[11]), cvtpk_s(p1[12], p1[13]), cvtpk_s(p1[14], p1[15])};
    pv_tile(o, vb, __builtin_bit_cast(bf16x8, w0), __builtin_bit_cast(bf16x8, w1), __builtin_bit_cast(bf16x8, w2), __builtin_bit_cast(bf16x8, w3));
}
template <bool FIRST> __device__ __forceinline__ void fold_branch(ALAS float* stg, const f32x16 (&o)[2], float fq, ALAS float* wsf, int r32, int hi) {
    if (hi == 0) wsf[r32] = fq;
    asm volatile("s_waitcnt lgkmcnt(0)" ::: "memory");
    ALAS float* sp = stg + hi * 256 + r32;
#pragma unroll
    for (int r = 0; r < 16; ++r) { const float f = wsf[4 * hi + (r & 3) + 8 * (r >> 2)]; const int ro = ((r & 3) + 8 * (r >> 2)) * 64;
        if (FIRST) { sp[ro] = o[0][r] * f; sp[ro + 32] = o[1][r] * f; } else { sp[ro] += o[0][r] * f; sp[ro + 32] += o[1][r] * f; } }
}

__device__ __forceinline__ void prompt_unit(Frame& F, int b, int h, int qb) {
    frame_fill(F);
    int tid = F.tid; asm volatile("" : "+v"(tid));
    const int lane = tid & 63, wid = F.wave, r32 = lane & 31, hi = lane >> 5, g = wid >> 1, qh = wid & 1;
    ALAS char* L = (ALAS char*)F.lds;
    ALAS float* wsf = (ALAS float*)(L + A_WS) + wid * 64;
    ALAS float* PBLK = (ALAS float*)(L + A_PBLK);
    ALAS unsigned* SELM = (ALAS unsigned*)(L + A_SELM);
    ALAS float* BON = (ALAS float*)(L + A_BON);
    ALAS float* stg = (ALAS float*)(L + A_OST) + wid * 2048;
    const int head = 4 * h + g, rowb = b * SEQ, q0 = qb * 64, qi = 32 * qh + r32;
    const size_t qrow = (size_t)(rowb + q0 + qi);
    const int krow = tid & 63, kch = tid >> 6;
    const int vrow = 16 * (wid & 3) + (lane >> 2), vcol = (wid >> 2) * 32 + (lane & 3) * 8;
    const bf16* KVh = F.KVb + (size_t)rowb * 768 + h * 64;
    const unsigned vb0 = (unsigned)(uintptr_t)(L + A_V) + ((lane >> 4) & 1) * 32 + (lane & 3) * 8 + (4 * hi + ((lane & 15) >> 2)) * 64;
    u32x4 kreg, vreg;
#define LOAD_TILE(t, kcol, vcolbase) do { kreg = *(const u32x4*)(KVh + (size_t)(64 * (t) + krow) * 768 + (kcol) + kch * 8); vreg = *(const u32x4*)(KVh + (size_t)(64 * (t) + vrow) * 768 + (vcolbase) + vcol); } while (0)
#define STORE_TILE(slot) do { *(ALAS u32x4*)(L + A_K + (slot) * 8192 + tid * 16) = kreg; *(ALAS u32x4*)(L + A_V + (slot) * 8192 + tid * 16) = vreg; } while (0)
    { const bf16* kc = F.KCP + (size_t)((b * 2 + h) * 64) * 64; const bf16* vc = F.VCP + (size_t)((b * 2 + h) * 64) * 64;
      kreg = *(const u32x4*)(kc + krow * 64 + kch * 8); vreg = *(const u32x4*)(vc + vrow * 64 + vcol); }
    for (int i = tid; i < 64 * 33; i += 512) PBLK[i] = 0.f;
    if (tid < 32) BON[tid] = (tid <= qb) ? ((tid == 0 || tid + 1 >= qb) ? 5.0f : 0.f) : NEGINF;
    bf16x8 qr[4];
#pragma unroll
    for (int d0 = 0; d0 < 4; ++d0) qr[d0] = *(const bf16x8*)(F.Qb + qrow * 512 + head * 64 + d0 * 16 + hi * 8);
    const float g_cmp = F.GATE[qrow * 32 + head * 3 + 0], g_sel = F.GATE[qrow * 32 + head * 3 + 1], g_win = F.GATE[qrow * 32 + head * 3 + 2];
    STORE_TILE(0);
    LOAD_TILE(0, 256, 384);
    __syncthreads();
    const int xq = qi - 4 * hi;
    f32x16 o[2], p0, p1;
#ifndef X_NOCMP
    {
        qk_tile(p0, p1, L + A_K, qr, r32, hi);
        const int ncv = (q0 + qi + 1) >> 5;
#pragma unroll
        for (int r = 0; r < 16; ++r) { const int c = (r & 3) + 8 * (r >> 2); if (c >= ncv - 4 * hi) p0[r] = NEGINF; if (c + 32 >= ncv - 4 * hi) p1[r] = NEGINF; }
        const float rm = rowmax32(p0, p1); const float m = (rm == NEGINF) ? 0.f : rm;
        float s = 0.f;
#pragma unroll
        for (int r = 0; r < 16; ++r) { p0[r] = __builtin_amdgcn_exp2f(p0[r] - m); p1[r] = __builtin_amdgcn_exp2f(p1[r] - m); s += p0[r] + p1[r]; }
        s = sum_halves(s);
        const float inv = (s > 0.f) ? 1.0f / s : 0.f;
#pragma unroll
        for (int k = 0; k < 8; ++k) { const int blk = 4 * (k >> 1) + 2 * hi + (k & 1);
            atomicAdd((float*)(PBLK + qi * 33 + blk), (p0[2 * k] + p0[2 * k + 1]) * inv); atomicAdd((float*)(PBLK + qi * 33 + blk + 16), (p1[2 * k] + p1[2 * k + 1]) * inv); }
        o[0] = (f32x16){}; o[1] = (f32x16){};
        pv_from_p(o, p0, p1, vb0);
        fold_branch<true>(stg, o, g_cmp * inv, wsf, r32, hi);
    }
#endif
    __syncthreads();
#ifndef X_NOTOPK
    {
        const int q = tid >> 3, part = tid & 7;
        int key[32];
#pragma unroll
        for (int j = 0; j < 32; ++j) key[j] = (int)((__float_as_uint(PBLK[q * 33 + j] + BON[j]) & ~31u) | (unsigned)(31 - j));
        unsigned bits = 0u;
#pragma unroll
        for (int ii = 0; ii < 4; ++ii) { const int i = part * 4 + ii; int ki = key[0];
#pragma unroll
            for (int j = 1; j < 32; ++j) ki = (j == i) ? key[j] : ki;
            unsigned rank = 0u;
#pragma unroll
            for (int j = 0; j < 32; ++j) rank += (unsigned)(ki - key[j]) >> 31;
            if (rank < 16u) bits |= 1u << i; }
        bits |= __shfl_xor(bits, 1); bits |= __shfl_xor(bits, 2); bits |= __shfl_xor(bits, 4);
        if (part == 0) SELM[q] = bits;
    }
#endif
    STORE_TILE(1);
    __syncthreads();
    const unsigned selm = SELM[qi];
    const int tw0 = (qb >= 8) ? qb - 8 : 0;
#ifndef X_NOSEL
    {
        SoftState st; st.m = MINIT; st.l = 0.f; o[0] = (f32x16){}; o[1] = (f32x16){};
        for (int t = 0; t <= qb; ++t) {
            const int slot = (t + 1) & 1;
            if (t < qb) LOAD_TILE(t + 1, 256, 384); else LOAD_TILE(tw0, 512, 640);
            const bool sel = (selm >> t) & 1u;
            if (__any(sel)) {
                qk_tile(p0, p1, L + A_K + slot * 8192, qr, r32, hi);
                if (t == qb) {
#pragma unroll
                    for (int r = 0; r < 16; ++r) { const int j = (r & 3) + 8 * (r >> 2); if (j > xq) p0[r] = NEGINF; if (j + 32 > xq) p1[r] = NEGINF; }
                }
                if (!sel) {
#pragma unroll
                    for (int r = 0; r < 16; ++r) { p0[r] = NEGINF; p1[r] = NEGINF; }
                }
                softmax_step(p0, p1, st, o, wsf, r32, hi);
                pv_from_p(o, p0, p1, vb0 + slot * 8192);
            }
            STORE_TILE(slot ^ 1);
            __syncthreads();
        }
        const float lt = sum_halves(st.l);
        fold_branch<false>(stg, o, g_sel / lt, wsf, r32, hi);
    }
#endif
#ifndef X_NOWIN
    {
        SoftState st; st.m = MINIT; st.l = 0.f; o[0] = (f32x16){}; o[1] = (f32x16){};
        int slot = qb & 1;
        for (int t = tw0; t <= qb; ++t) {
            if (t < qb) LOAD_TILE(t + 1, 512, 640);
            qk_tile(p0, p1, L + A_K + slot * 8192, qr, r32, hi);
            if (t == qb) {
#pragma unroll
                for (int r = 0; r < 16; ++r) { const int j = (r & 3) + 8 * (r >> 2); if (j > xq) p0[r] = NEGINF; if (j + 32 > xq) p1[r] = NEGINF; }
            }
            if (t + 8 == qb) {
#pragma unroll
                for (int r = 0; r < 16; ++r) { const int j = (r & 3) + 8 * (r >> 2); if (j < xq) p0[r] = NEGINF; if (j + 32 < xq) p1[r] = NEGINF; }
            }
            softmax_step(p0, p1, st, o, wsf, r32, hi);
            pv_from_p(o, p0, p1, vb0 + slot * 8192);
            if (t < qb) STORE_TILE(slot ^ 1);
            __syncthreads();
            slot ^= 1;
        }
        const float lt = sum_halves(st.l);
        fold_branch<false>(stg, o, g_win / lt, wsf, r32, hi);
    }
#endif
#undef LOAD_TILE
#undef STORE_TILE
    {
        asm volatile("s_waitcnt lgkmcnt(0)" ::: "memory");
        bf16* Ow = F.AO + (size_t)(rowb + q0 + 32 * qh) * D + 512 + head * 64;
#pragma unroll
        for (int i = 0; i < 4; ++i) { const int row = i * 8 + (lane >> 3), ch = lane & 7; const ALAS pg8::f32x4* sp = (const ALAS pg8::f32x4*)(stg + row * 64 + ch * 8);
            const pg8::f32x4 v0 = sp[0], v1 = sp[1]; u32x4 w; w.x = cvtpk_s(v0[0], v0[1]); w.y = cvtpk_s(v0[2], v0[3]); w.z = cvtpk_s(v1[0], v1[1]); w.w = cvtpk_s(v1[2], v1[3]);
            *(u32x4*)(Ow + (size_t)row * D + ch * 8) = w; }
    }
}

struct KeyState { float m[4], l[4], o[4][8]; };
__device__ __forceinline__ void ks_init(KeyState& S) {
#pragma unroll
    for (int g = 0; g < 4; ++g) { S.m[g] = MINIT; S.l[g] = 0.f;
#pragma unroll
        for (int d = 0; d < 8; ++d) S.o[g][d] = 0.f; }
}
__device__ __forceinline__ void ks_key(KeyState& S, const float (&q)[4][8], const pg8::f32x4 k0, const pg8::f32x4 k1, const pg8::f32x4 v0, const pg8::f32x4 v1, bool valid) {
    float s[4];
#pragma unroll
    for (int g = 0; g < 4; ++g) { float a = q[g][0] * k0[0] + q[g][1] * k0[1] + q[g][2] * k0[2] + q[g][3] * k0[3] + q[g][4] * k1[0] + q[g][5] * k1[1] + q[g][6] * k1[2] + q[g][7] * k1[3];
        a += __shfl_xor(a, 1); a += __shfl_xor(a, 2); a += __shfl_xor(a, 4); s[g] = valid ? a : NEGINF; }
#pragma unroll
    for (int g = 0; g < 4; ++g) {
        if (s[g] > S.m[g] + THR) { const float al = __builtin_amdgcn_exp2f(S.m[g] - s[g]); S.m[g] = s[g]; S.l[g] *= al;
#pragma unroll
            for (int d = 0; d < 8; ++d) S.o[g][d] *= al; }
        const float p = __builtin_amdgcn_exp2f(s[g] - S.m[g]); S.l[g] += p;
#pragma unroll
        for (int d = 0; d < 4; ++d) { S.o[g][d] += p * v0[d]; S.o[g][4 + d] += p * v1[d]; }
    }
}
__device__ __forceinline__ void ks_merge_publish(KeyState& S, ALAS float* ML, ALAS float* MO, int wid, int lane) {
#pragma unroll
    for (int sh = 8; sh < 64; sh <<= 1) {
#pragma unroll
        for (int g = 0; g < 4; ++g) { const float mo = __shfl_xor(S.m[g], sh), lo = __shfl_xor(S.l[g], sh); const float mn = fmaxf(S.m[g], mo);
            const float a = __builtin_amdgcn_exp2f(S.m[g] - mn), bb = __builtin_amdgcn_exp2f(mo - mn); S.l[g] = S.l[g] * a + lo * bb;
#pragma unroll
            for (int d = 0; d < 8; ++d) { const float oo = __shfl_xor(S.o[g][d], sh); S.o[g][d] = S.o[g][d] * a + oo * bb; }
            S.m[g] = mn; }
    }
    if (lane < 8) {
#pragma unroll
        for (int g = 0; g < 4; ++g) { if (lane == 0) { ML[(wid * 4 + g) * 2] = S.m[g]; ML[(wid * 4 + g) * 2 + 1] = S.l[g]; }
#pragma unroll
            for (int d = 0; d < 8; ++d) MO[(wid * 4 + g) * 64 + lane * 8 + d] = S.o[g][d]; }
    }
}
__device__ __forceinline__ void ks_combine(ALAS float* ML, ALAS float* MO, ALAS float* RESb, int tid) {
    if (tid < 256) { const int g = tid >> 6, d = tid & 63; float M = MINIT;
#pragma unroll
        for (int w = 0; w < 8; ++w) M = fmaxf(M, ML[(w * 4 + g) * 2]);
        float Ls = 0.f, Os = 0.f;
#pragma unroll
        for (int w = 0; w < 8; ++w) { const float f = __builtin_amdgcn_exp2f(ML[(w * 4 + g) * 2] - M); Ls += ML[(w * 4 + g) * 2 + 1] * f; Os += MO[(w * 4 + g) * 64 + d] * f; }
        RESb[g * 64 + d] = Os / Ls; }
}

__device__ __forceinline__ void sample_unit(Frame& F, int bs, int h) {
    frame_fill(F);
    int tid = F.tid; asm volatile("" : "+v"(tid));
    const int lane = tid & 63, wid = F.wave, kl = lane >> 3, dp = lane & 7;
    ALAS char* L = (ALAS char*)F.lds;
    ALAS float* SC = (ALAS float*)(L + S_SC); ALAS float* PH = (ALAS float*)(L + S_PH); ALAS float* PBL = (ALAS float*)(L + S_PBL);
    ALAS int* SEL = (ALAS int*)(L + S_SEL); ALAS float* ML = (ALAS float*)(L + S_ML); ALAS float* MO = (ALAS float*)(L + S_MO); ALAS float* RES = (ALAS float*)(L + S_RES);
    const size_t row = (size_t)(MP + bs);
    float q[4][8];
#pragma unroll
    for (int g = 0; g < 4; ++g) { const u32x4 v = *(const u32x4*)(F.Qb + row * 512 + (4 * h + g) * 64 + dp * 8);
        q[g][0] = __uint_as_float(v.x << 16); q[g][1] = __uint_as_float(v.x & 0xffff0000u); q[g][2] = __uint_as_float(v.y << 16); q[g][3] = __uint_as_float(v.y & 0xffff0000u);
        q[g][4] = __uint_as_float(v.z << 16); q[g][5] = __uint_as_float(v.z & 0xffff0000u); q[g][6] = __uint_as_float(v.w << 16); q[g][7] = __uint_as_float(v.w & 0xffff0000u); }
    { const int c = 8 * wid + kl; const float* kc = F.KCVS + ((size_t)bs * 64 + c) * 256 + h * 64 + dp * 8;
      const pg8::f32x4 k0 = *(const pg8::f32x4*)kc, k1 = *(const pg8::f32x4*)(kc + 4);
#pragma unroll
      for (int g = 0; g < 4; ++g) { float a = q[g][0] * k0[0] + q[g][1] * k0[1] + q[g][2] * k0[2] + q[g][3] * k0[3] + q[g][4] * k1[0] + q[g][5] * k1[1] + q[g][6] * k1[2] + q[g][7] * k1[3];
          a += __shfl_xor(a, 1); a += __shfl_xor(a, 2); a += __shfl_xor(a, 4); if (dp == 0) SC[g * 64 + c] = a; } }
    __syncthreads();
    if (wid < 4) { const float s = SC[wid * 64 + lane]; float mx = s;
#pragma unroll
        for (int o = 1; o < 64; o <<= 1) mx = fmaxf(mx, __shfl_xor(mx, o));
        const float p = __builtin_amdgcn_exp2f(s - mx); const float sum = wave_sum(p); PH[wid * 64 + lane] = p / sum; }
    __syncthreads();
    if (wid == 0) {
        float pb = 0.f;
        if (lane < 32) pb = (PH[2 * lane] + PH[2 * lane + 1]) + (PH[64 + 2 * lane] + PH[64 + 2 * lane + 1]) + (PH[128 + 2 * lane] + PH[128 + 2 * lane + 1]) + (PH[192 + 2 * lane] + PH[192 + 2 * lane + 1]);
        const float sc = (lane <= 32) ? pb + ((lane == 0 || lane >= 31) ? 5.0f : 0.f) : NEGINF;
        const int key = (int)((__float_as_uint(sc) & ~63u) | (unsigned)(63 - lane));
        ((ALAS int*)PBL)[lane] = key;
        asm volatile("s_waitcnt lgkmcnt(0)" ::: "memory");
        unsigned rank = 0u;
        for (int j = 0; j < 33; ++j) rank += (unsigned)(key - ((ALAS int*)PBL)[j]) >> 31;
        const bool selb = (lane < 32) && (rank < 16u);
        const unsigned long long bal = __ballot(selb);
        if (selb) SEL[__popcll(bal & ((1ull << lane) - 1ull))] = lane;
        if (lane == 0) SEL[16] = __popcll(bal);
    }
    __syncthreads();
    const int nsel = SEL[16];
    if (tid < 256) { const int g = tid >> 6, d = tid & 63; const float* vc = F.KCVS + (size_t)bs * 64 * 256 + 128 + h * 64 + d; float a = 0.f;
#pragma unroll 8
        for (int c = 0; c < 64; ++c) a += PH[g * 64 + c] * vc[(size_t)c * 256];
        RES[g * 64 + d] = a; }
    KeyState S; ks_init(S);
    for (int e = wid; e < nsel; e += 8) {
        const int B = SEL[e]; const int page = F.page_table[bs * 16 + (B >> 1)];
        const float* base = F.cache_kv + ((size_t)page * 128 + (B & 1) * 64 + kl) * 512 + 256 + h * 64 + dp * 8;
#pragma unroll
        for (int half = 0; half < 2; ++half) {
            pg8::f32x4 kk[4][2], vv[4][2];
#pragma unroll
            for (int it = 0; it < 4; ++it) { const float* p = base + (size_t)((half * 4 + it) * 8) * 512;
                kk[it][0] = __builtin_nontemporal_load((const pg8::f32x4*)p); kk[it][1] = __builtin_nontemporal_load((const pg8::f32x4*)(p + 4));
                vv[it][0] = __builtin_nontemporal_load((const pg8::f32x4*)(p + 128)); vv[it][1] = __builtin_nontemporal_load((const pg8::f32x4*)(p + 132)); }
#pragma unroll
            for (int it = 0; it < 4; ++it) ks_key(S, q, kk[it][0], kk[it][1], vv[it][0], vv[it][1], true);
        }
    }
    if (wid == 0) {
        const float* p = F.out + O_KVS + (size_t)bs * 512 + 256 + h * 64 + dp * 8;
        ks_key(S, q, *(const pg8::f32x4*)p, *(const pg8::f32x4*)(p + 4), *(const pg8::f32x4*)(p + 128), *(const pg8::f32x4*)(p + 132), kl == 0);
    }
    ks_merge_publish(S, ML, MO, wid, lane);
    __syncthreads();
    ks_combine(ML, MO, RES + 256, tid);
    __syncthreads();
    ks_init(S);
    {
        const float* base = F.cache_win + ((size_t)bs * 512 + 64 * wid + kl) * 256 + h * 64 + dp * 8;
        float* ob = F.out + O_WINS + ((size_t)bs * 512 + 64 * wid + kl) * 256 + h * 64 + dp * 8;
#pragma unroll
        for (int half = 0; half < 2; ++half) {
            pg8::f32x4 kk[4][2], vv[4][2];
#pragma unroll
            for (int it = 0; it < 4; ++it) { const float* p = base + (size_t)((half * 4 + it) * 8) * 256;
                kk[it][0] = __builtin_nontemporal_load((const pg8::f32x4*)p); kk[it][1] = __builtin_nontemporal_load((const pg8::f32x4*)(p + 4));
                vv[it][0] = __builtin_nontemporal_load((const pg8::f32x4*)(p + 128)); vv[it][1] = __builtin_nontemporal_load((const pg8::f32x4*)(p + 132)); }
#pragma unroll
            for (int it = 0; it < 4; ++it) {
                const int j = 64 * wid + (half * 4 + it) * 8 + kl;
                if (j >= 1) { float* o = ob + (ptrdiff_t)((half * 4 + it) * 8 - 1) * 256; *(pg8::f32x4*)o = kk[it][0]; *(pg8::f32x4*)(o + 4) = kk[it][1]; *(pg8::f32x4*)(o + 128) = vv[it][0]; *(pg8::f32x4*)(o + 132) = vv[it][1]; }
                ks_key(S, q, kk[it][0], kk[it][1], vv[it][0], vv[it][1], true);
            }
        }
    }
    if (wid == 0) {
        const float* p = F.out + O_WINS + ((size_t)bs * 512 + 511) * 256 + h * 64 + dp * 8;
        ks_key(S, q, *(const pg8::f32x4*)p, *(const pg8::f32x4*)(p + 4), *(const pg8::f32x4*)(p + 128), *(const pg8::f32x4*)(p + 132), kl == 0);
    }
    ks_merge_publish(S, ML, MO, wid, lane);
    __syncthreads();
    ks_combine(ML, MO, RES + 512, tid);
    __syncthreads();
    if (tid < 256) { const int g = tid >> 6, d = tid & 63; const float* gt = F.GATE + row * 32 + (4 * h + g) * 3;
        const float v = gt[0] * RES[g * 64 + d] + gt[1] * RES[256 + g * 64 + d] + gt[2] * RES[512 + g * 64 + d];
        F.AO[row * D + 512 + (4 * h + g) * 64 + d] = (bf16)f2bf(v); }
    __syncthreads();
}

__device__ __forceinline__ void attn_phase(Frame& F) {
    ALAS unsigned* QS = (ALAS unsigned*)((ALAS char*)F.lds + A_QSLOT);
    for (;;) {
        frame_fill(F);
        if (F.tid == 0) QS[0] = __hip_atomic_fetch_add((unsigned*)(F.ctl + CW_QUEUE), 1u, __ATOMIC_RELAXED, __HIP_MEMORY_SCOPE_AGENT);
        __syncthreads();
        const unsigned p = QS[0];
        __syncthreads();
        if (p >= 768u) break;
        const unsigned k = p / 3u, r = p % 3u;
#ifndef NO_SAMPLE
        if (r == 2u) sample_unit(F, (int)(k >> 1), (int)(k & 1u));
#else
        if (r == 2u) {}
#endif
#ifndef NO_PROMPT
        else { const unsigned u = 2u * k + r; prompt_unit(F, (int)((u & 15u) >> 1), (int)(u & 1u), 31 - (int)(u >> 4)); }
#endif
    }
}
#undef ALAS
}

struct Args { const void* in[19]; float* out; unsigned char* ws; int ph_lo, ph_hi, li, pad; };
__global__ void __launch_bounds__(NWAVES * 64, 2) mk_fwd(Args args) {
    extern __shared__ __attribute__((aligned(16))) unsigned char lds[];
    Frame F;
    F.lds = (LAS unsigned char*)lds;
    F.MISC = (volatile LAS unsigned*)(F.lds + MISC_OFF);
    F.tid = threadIdx.x; F.lane = F.tid & 63; F.wave = __builtin_amdgcn_readfirstlane(F.tid >> 6);
    F.G = gridDim.x; { const int bx = blockIdx.x; F.vcu = (F.G % 8 == 0) ? (bx % 8) * (F.G / 8) + bx / 8 : bx; }
    F.ka = (kptr_t)__builtin_amdgcn_kernarg_segment_ptr();
    frame_fill(F);
    for (int u = F.tid; u < (LDS_BYTES - LDSCTL_OFF) / 4; u += NWAVES * 64) ((LAS unsigned*)(F.lds + LDSCTL_OFF))[u] = 0u;
    __syncthreads();
    XcdBarrier bar; bar.bar = (unsigned*)(F.ctl + CW_BAR); bar.x = 0; bar.st = nullptr;
    if (N_LAUNCHES == 1) bar = xcd_barrier_post((unsigned*)(F.ctl + CW_BAR), F.MISC + 8);
#define GRID_BAR() do { if (N_LAUNCHES == 1) { xcd_barrier(bar); } } while (0)
    const int lo = args.ph_lo, hi = args.ph_hi;
#ifndef PH_MASK
#define PH_MASK 255
#endif
#define IN(k) (((PH_MASK >> (k)) & 1) && lo <= (k) && (k) < hi)
#define BOTH(k) (IN(k) && IN((k) + 1))

    if (IN(0)) { frame_fill(F); p0_prologue(F); if (BOTH(0)) GRID_BAR(); }
    if (IN(1)) {
        frame_fill(F);
        pg8::Gemm g{F.XN, F.Win_t, MALL, NINP, D}; pg8::StaticOrder S; S.init(MALL, NINP, F.G, (int)blockIdx.x);
        pg8::EpiInProj E{F.Gb, F.Qb, F.KVb, F.GATE, F.out};
        pg8::gemm_phase<pg8::EpiInProj, pg8::StaticOrder, PG8_ALIGN, PG8_SP2>(F.lds + RING_OFF, g, S, E);
        if (BOTH(1)) GRID_BAR();
    }
    if (IN(2)) { frame_fill(F); p2_phase(F); if (BOTH(2)) GRID_BAR(); }
    if (IN(3)) { frame_fill(F); att::attn_phase(F); if (BOTH(3)) GRID_BAR(); }
    if (IN(4)) {
        frame_fill(F);
        pg8::Gemm g{F.AO, F.Wout_t, MP, D, D}; pg8::StaticOrder S; S.init(MP, D, F.G, (int)blockIdx.x);
        pg8::EpiOutProj E{F.x_prompt, F.out + O_YP, F.HB, F.g_mlp, F.SS1};
        pg8::gemm_phase<pg8::EpiOutProj, pg8::StaticOrder, PG8_ALIGN, PG8_SP2>(F.lds + RING_OFF, g, S, E);
        frame_fill(F);
        for (int it = F.vcu; it < 64; it += F.G) s_outproj_item(F, it);
        if (BOTH(4)) GRID_BAR();
    }
    if (IN(5)) {
        frame_fill(F);
        pg8::Gemm g{F.HB, F.Wup_t, MP, FF, D}; pg8::StaticOrder S; S.init(MP, FF, F.G, (int)blockIdx.x);
        pg8::EpiUp E{F.MID, F.SS1};
        pg8::gemm_phase<pg8::EpiUp, pg8::StaticOrder, PG8_ALIGN, PG8_SP2>(F.lds + RING_OFF, g, S, E);
        frame_fill(F);
        for (int it = F.vcu; it < 256; it += F.G) s_up_item(F, it);
        if (BOTH(5)) GRID_BAR();
    }
    if (IN(6)) {
        frame_fill(F);
        pg8::Gemm g{F.MID, F.Wdn_t, MP, D, FF}; pg8::StaticOrder S; S.init(MP, D, F.G, (int)blockIdx.x);
        pg8::EpiDown E{F.out + O_YP, F.SS2};
        pg8::gemm_phase<pg8::EpiDown, pg8::StaticOrder, PG8_ALIGN, PG8_SP2>(F.lds + RING_OFF, g, S, E);
        frame_fill(F);
        for (int it = F.vcu; it < 256; it += F.G) s_down_item(F, it);
        if (BOTH(6)) GRID_BAR();
    }
    if (IN(7)) { frame_fill(F); p7_phase(F); }
#undef IN
#undef BOTH
#undef GRID_BAR
}

extern "C" void kernel_launch(void* const* d_in, const int* in_sizes, int n_in, void* d_out, int out_size, void* d_ws, size_t ws_size, hipStream_t stream) {
    static int grid = 0;
    if (grid == 0) {
        if (n_in != 19 || in_sizes[0] != MP * D || out_size != (int)O_END || ws_size < WS_END) {
            fprintf(stderr, "kernel_launch: unexpected problem (n_in %d, in0 %d, out %d, ws %zu); nothing launched\n", n_in, n_in > 0 ? in_sizes[0] : -1, out_size, ws_size); grid = -1; return; }
        int dev = 0, cus = 0, per_cu = 0;
        if (hipGetDevice(&dev) != hipSuccess || hipDeviceGetAttribute(&cus, hipDeviceAttributeMultiprocessorCount, dev) != hipSuccess) { fprintf(stderr, "kernel_launch: device query failed\n"); grid = -1; return; }
        if (hipFuncSetAttribute((const void*)mk_fwd, hipFuncAttributeMaxDynamicSharedMemorySize, LDS_BYTES) != hipSuccess) { fprintf(stderr, "kernel_launch: hipFuncSetAttribute failed\n"); grid = -1; return; }
        if (hipOccupancyMaxActiveBlocksPerMultiprocessor(&per_cu, (const void*)mk_fwd, NWAVES * 64, LDS_BYTES) != hipSuccess || per_cu < 1) {
            fprintf(stderr, "kernel_launch: occupancy query reports %d workgroups per CU; nothing launched\n", per_cu); (void)hipGetLastError(); grid = -1; return; }
        grid = cus;
    }
    if (grid < 0) return;
    if (hipMemsetAsync((char*)d_ws + WS_CTL, 0, CTL_ZERO_BYTES, stream) != hipSuccess) { fprintf(stderr, "kernel_launch: hipMemsetAsync failed\n"); return; }
    Args a{};
    for (int i = 0; i < 19; ++i) a.in[i] = d_in[i];
    a.out = (float*)d_out; a.ws = (unsigned char*)d_ws;
    for (int li = 0; li < N_LAUNCHES; ++li) {
        if (N_LAUNCHES == 1) { a.ph_lo = 0; a.ph_hi = N_PHASES; } else { a.ph_lo = li; a.ph_hi = li + 1; }
        a.li = li;
        hipLaunchKernelGGL(mk_fwd, dim3(grid), dim3(NWAVES * 64), LDS_BYTES, stream, a);
        const hipError_t le = hipPeekAtLastError();
        if (le != hipSuccess) { fprintf(stderr, "kernel_launch: launch %d failed: %s\n", li, hipGetErrorName(le)); break; }
    }
}
```

```cpp
#include <hip/hip_runtime.h>
#include <cstdio>
#include <cstdint>
namespace pg8 {
#define PG8_LAS __attribute__((address_space(3)))
typedef unsigned short bf16_t;
typedef short bf16x8 __attribute__((ext_vector_type(8)));
typedef float f32x4 __attribute__((ext_vector_type(4)));
typedef unsigned u32x4 __attribute__((ext_vector_type(4)));
constexpr int BM = 256, BK = 64, HALF = 128, HTB = HALF * BK * 2  , STAGE_BYTES = 8 * HTB, NXCD = 8, WGM = 8;

__host__ __device__ __forceinline__ int lds_byte(int r, int c) { const int st = (r >> 4) * 2 + (c >> 5), rr = r & 15, cc = c & 31, ob = rr * 64 + cc * 2; return st * 1024 + (ob ^ (((ob >> 9) & 1) << 5)); }
__host__ __device__ __forceinline__ void stage_rc(int b, int& R, int& C) { const int st = b / 1024, sb = b % 1024, swz = sb ^ (((sb >> 9) & 1) << 5); R = (st >> 1) * 16 + swz / 64; C = (st & 1) * 32 + (swz % 64) / 2; }
__host__ __device__ __forceinline__ int perm32(int rho) { const int n = rho >> 4, i = rho & 15; return 8 * (i >> 2) + 4 * n + (i & 3); }

struct Unit { int pm, pn; };
struct Gemm { const bf16_t* A; const bf16_t* Bt; int M, N, K; };

struct StaticOrder {
    int nM, nN, nwg, G, c;
    __host__ __device__ void init(int M, int N, int G_, int c_) { nM = M / BM; nN = N / BM; nwg = nM * nN; G = G_; c = c_; }
    __host__ __device__ bool next(int i, Unit& u) const {
        const long L = (long)i * G + c; if (L >= nwg) return false;
        int wgid = (int)L; { const int q = nwg / NXCD, r = nwg % NXCD, xcd = wgid % NXCD, off = wgid / NXCD; wgid = (xcd < r ? xcd * (q + 1) : r * (q + 1) + (xcd - r) * q) + off; }
        const int nig = WGM * nN, gid = wgid / nig, fm = gid * WGM, gsz = (nM - fm) < WGM ? (nM - fm) : WGM;
        u.pm = fm + ((wgid % nig) % gsz); u.pn = (wgid % nig) / gsz; return true;
    }
    __device__ __forceinline__ void a_ready(const Unit&) const {}
    __device__ __forceinline__ void done(const Unit&) const {}
};


constexpr int MP = 16384, MS = 128, MALL = 16640;
constexpr int NVALID = MP + MS;
constexpr size_t O_YP = 0, O_YS = 16777216, O_KVP = 16908288, O_WINP = 25296896, O_CONVP = 26345472, O_KVS = 26468352, O_WINS = 26533888, O_CONVS = 43311104, O_END = 45277184;
constexpr float QSCALE = 0.125f * 1.4426950408889634f;

__device__ __forceinline__ unsigned cvt_pk_bf16(float lo, float hi) { unsigned r; asm volatile("v_cvt_pk_bf16_f32 %0, %1, %2" : "=v"(r) : "v"(lo), "v"(hi)); return r; }
__device__ __forceinline__ float fast_sigmoid(float x) { return __builtin_amdgcn_rcpf(1.0f + __builtin_amdgcn_exp2f(-1.4426950408889634f * x)); }
__device__ __forceinline__ u32x4 pack8(const f32x4 a, const f32x4 b) { u32x4 w; w.x = cvt_pk_bf16(a[0], a[1]); w.y = cvt_pk_bf16(a[2], a[3]); w.z = cvt_pk_bf16(b[0], b[1]); w.w = cvt_pk_bf16(b[2], b[3]); return w; }

struct EpiInProj {
    static constexpr bool PERM = true, AFTER_DRAIN = false;
    bf16_t* G; bf16_t* Q; bf16_t* KV; float* GATE; float* out;
    __device__ __forceinline__ void operator()(const f32x4 (&acc)[2][2][4][2], const Unit& u, int wr, int wc, int fr, int fq) const {
        const int pn = u.pn; const int rb = u.pm * BM + wr * 64 + fr; const int cl = wc * 32 + 8 * fq;
        if (pn < 4) {
#pragma unroll
            for (int ai = 0; ai < 2; ++ai)
#pragma unroll
                for (int m = 0; m < 4; ++m) { const int row = rb + ai * HALF + m * 16; if (row >= NVALID) continue;
                    f32x4 g0, g1;
#pragma unroll
                    for (int e = 0; e < 4; ++e) { g0[e] = acc[ai][0][m][0][e] * fast_sigmoid(acc[ai][1][m][0][e]); g1[e] = acc[ai][0][m][1][e] * fast_sigmoid(acc[ai][1][m][1][e]); }
                    const int c = 128 * pn + cl;
                    *(u32x4*)(G + (size_t)row * 512 + c) = pack8(g0, g1);
                    float* dst = nullptr;
                    if (row < MP) { const int t = row & 2047; if (t >= 2018) dst = out + O_CONVP + ((size_t)((row >> 11) * 30 + t - 2018) * 512 + c); }
                    else dst = out + O_CONVS + ((size_t)((row - MP) * 30 + 29) * 512 + c);
                    if (dst) { *(f32x4*)dst = g0; *(f32x4*)(dst + 4) = g1; } }
        } else if (pn < 6) {
#pragma unroll
            for (int ai = 0; ai < 2; ++ai)
#pragma unroll
                for (int m = 0; m < 4; ++m) { const int row = rb + ai * HALF + m * 16;
#pragma unroll
                    for (int bj = 0; bj < 2; ++bj) { const int c = 256 * (pn - 4) + 128 * bj + cl;
                        *(u32x4*)(Q + (size_t)row * 512 + c) = pack8(acc[ai][bj][m][0] * QSCALE, acc[ai][bj][m][1] * QSCALE); } }
        } else if (pn < 8) {
#pragma unroll
            for (int ai = 0; ai < 2; ++ai)
#pragma unroll
                for (int m = 0; m < 4; ++m) { const int row = rb + ai * HALF + m * 16; if (row >= NVALID) continue;
#pragma unroll
                    for (int bj = 0; bj < 2; ++bj) { const int c = 256 * (pn - 6) + 128 * bj + cl;
                        *(u32x4*)(KV + (size_t)row * 768 + c) = pack8(acc[ai][bj][m][0], acc[ai][bj][m][1]);
                        float* dst = (row < MP) ? out + O_KVP + (size_t)row * 512 + c : out + O_KVS + (size_t)(row - MP) * 512 + c;
                        *(f32x4*)dst = acc[ai][bj][m][0]; *(f32x4*)(dst + 4) = acc[ai][bj][m][1]; } }
        } else if (pn == 8) {
#pragma unroll
            for (int ai = 0; ai < 2; ++ai)
#pragma unroll
                for (int m = 0; m < 4; ++m) { const int row = rb + ai * HALF + m * 16; if (row >= NVALID) continue;
#pragma unroll
                    for (int bj = 0; bj < 2; ++bj) { const int c = 128 * bj + cl;
                        *(u32x4*)(KV + (size_t)row * 768 + 512 + c) = pack8(acc[ai][bj][m][0], acc[ai][bj][m][1]);
                        float* dst = nullptr;
                        if (row < MP) { const int t = row & 2047; if (t >= 1536) dst = out + O_WINP + ((size_t)((row >> 11) * 512 + t - 1536) * 256 + c); }
                        else dst = out + O_WINS + ((size_t)((row - MP) * 512 + 511) * 256 + c);
                        if (dst) { *(f32x4*)dst = acc[ai][bj][m][0]; *(f32x4*)(dst + 4) = acc[ai][bj][m][1]; } } }
        } else {
            if (wc == 0 && fq < 3) {
#pragma unroll
                for (int ai = 0; ai < 2; ++ai)
#pragma unroll
                    for (int m = 0; m < 4; ++m) { const int row = rb + ai * HALF + m * 16; if (row >= NVALID) continue;
                        f32x4 g0, g1;
#pragma unroll
                        for (int e = 0; e < 4; ++e) { g0[e] = fast_sigmoid(acc[ai][0][m][0][e]); g1[e] = fast_sigmoid(acc[ai][0][m][1][e]); }
                        float* dst = GATE + (size_t)row * 32 + 8 * fq; *(f32x4*)dst = g0; *(f32x4*)(dst + 4) = g1; }
            }
        }
    }
};

struct EpiOutProj {
    static constexpr bool PERM = false, AFTER_DRAIN = false;
    const float* x; float* h; bf16_t* hb; const float* g; float* ss;
    __device__ __forceinline__ void operator()(const f32x4 (&acc)[2][2][4][2], const Unit& u, int wr, int wc, int fr, int fq) const {
        const int col0 = u.pn * BM + wc * 32 + 4 * fq;
        f32x4 gv[2][2];
#pragma unroll
        for (int bj = 0; bj < 2; ++bj)
#pragma unroll
            for (int n = 0; n < 2; ++n) gv[bj][n] = *(const f32x4*)(g + col0 + bj * HALF + n * 16);
#pragma unroll
        for (int ai = 0; ai < 2; ++ai)
#pragma unroll
            for (int m = 0; m < 4; ++m) { const int row = u.pm * BM + ai * HALF + wr * 64 + m * 16 + fr; const size_t off = (size_t)row * 1024 + col0; float s = 0.f;
#pragma unroll
                for (int bj = 0; bj < 2; ++bj)
#pragma unroll
                    for (int n = 0; n < 2; ++n) { const f32x4 xv = *(const f32x4*)(x + off + bj * HALF + n * 16); const f32x4 hv = xv + acc[ai][bj][m][n];
                        *(f32x4*)(h + off + bj * HALF + n * 16) = hv; s += (hv[0] * hv[0] + hv[1] * hv[1]) + (hv[2] * hv[2] + hv[3] * hv[3]);
                        const f32x4 hg = hv * gv[bj][n]; unsigned w0 = cvt_pk_bf16(hg[0], hg[1]), w1 = cvt_pk_bf16(hg[2], hg[3]);
                        *(unsigned long long*)(hb + off + bj * HALF + n * 16) = (unsigned long long)w0 | ((unsigned long long)w1 << 32); }
                s += __shfl_xor(s, 16); s += __shfl_xor(s, 32);
                if (fq == 0) atomicAdd(ss + row, s); }
    }
};
struct EpiUp {
    static constexpr bool PERM = true, AFTER_DRAIN = false;
    bf16_t* mid; const float* ss;
    __device__ __forceinline__ void operator()(const f32x4 (&acc)[2][2][4][2], const Unit& u, int wr, int wc, int fr, int fq) const {
        const int col0 = u.pn * BM + wc * 32 + 8 * fq;
#pragma unroll
        for (int ai = 0; ai < 2; ++ai)
#pragma unroll
            for (int m = 0; m < 4; ++m) { const int row = u.pm * BM + ai * HALF + wr * 64 + m * 16 + fr; const float r = __builtin_amdgcn_rsqf(ss[row] * (1.0f / 1024.0f) + 1e-6f);
#pragma unroll
                for (int bj = 0; bj < 2; ++bj) { f32x4 a = acc[ai][bj][m][0] * r, b = acc[ai][bj][m][1] * r;
#pragma unroll
                    for (int e = 0; e < 4; ++e) { const float p = fmaxf(a[e], 0.f), q = fmaxf(b[e], 0.f); a[e] = p * p; b[e] = q * q; }
                    *(u32x4*)(mid + (size_t)row * 4096 + col0 + bj * HALF) = pack8(a, b); } }
    }
};
struct EpiDown {
    static constexpr bool PERM = false, AFTER_DRAIN = false;
    const float* h; float* hd; float* ss;
    __device__ __forceinline__ void operator()(const f32x4 (&acc)[2][2][4][2], const Unit& u, int wr, int wc, int fr, int fq) const {
        const int col0 = u.pn * BM + wc * 32 + 4 * fq;
#pragma unroll
        for (int ai = 0; ai < 2; ++ai)
#pragma unroll
            for (int m = 0; m < 4; ++m) { const int row = u.pm * BM + ai * HALF + wr * 64 + m * 16 + fr; const size_t off = (size_t)row * 1024 + col0; float s = 0.f;
#pragma unroll
                for (int bj = 0; bj < 2; ++bj)
#pragma unroll
                    for (int n = 0; n < 2; ++n) { const f32x4 hv = *(const f32x4*)(h + off + bj * HALF + n * 16) + acc[ai][bj][m][n];
                        *(f32x4*)(hd + off + bj * HALF + n * 16) = hv; s += (hv[0] * hv[0] + hv[1] * hv[1]) + (hv[2] * hv[2] + hv[3] * hv[3]); }
                s += __shfl_xor(s, 16); s += __shfl_xor(s, 32);
                if (fq == 0) atomicAdd(ss + row, s); }
    }
};
template <class Epi, class Sched, bool ALIGN_EPI = false, bool SP2 = false>
__device__ __forceinline__ void gemm_phase(PG8_LAS unsigned char* lds, const Gemm g, const Sched& S, const Epi& E) {
    const int tid = threadIdx.x, wid = __builtin_amdgcn_readfirstlane(tid >> 6), lane = tid & 63, wr = wid >> 2, wc = wid & 3, fr = lane & 15, fq = lane >> 4;
    const int K = g.K, nt = K / BK;
    unsigned voffA[2], voffB[2];
#pragma unroll
    for (int i = 0; i < 2; ++i) { int R, C; stage_rc(tid * 16 + i * 8192, R, C); const int Rb = Epi::PERM ? ((R & ~31) + perm32(R & 31)) : R;
        voffA[i] = (unsigned)(R * K + C) * 2u; voffB[i] = (unsigned)(Rb * K + C) * 2u; }
    const size_t kstep = (size_t)(BK * 2);
    const size_t hstep = (size_t)HALF * K * 2;
    const size_t tstep = 2 * hstep;
    const unsigned ldsw = (unsigned)wid * 1024u;
    const int aoff = lds_byte(wr * 64 + fr, fq * 8), boff = lds_byte(wc * 32 + fr, fq * 8);
#define PG8_SA(b, h) (((b) * 2 + (h)) * HTB)
#define PG8_SB(b, h) ((4 + (b) * 2 + (h)) * HTB)
#define PG8_STAGE(bufoff, gbase, voff) do { _Pragma("unroll") for (int _i = 0; _i < 2; ++_i) \
        __builtin_amdgcn_global_load_lds((const unsigned*)((const char*)(gbase) + (voff)[_i]), (PG8_LAS unsigned*)(lds + (bufoff) + ldsw + _i * 8192), 16, 0, 0); } while (0)
#define PG8_LDA(dst, b, h) do { _Pragma("unroll") for (int m = 0; m < 4; ++m) _Pragma("unroll") for (int k = 0; k < 2; ++k) dst[m][k] = *(const PG8_LAS bf16x8*)(lds + PG8_SA(b, h) + aoff + m * 2048 + k * 1024); } while (0)
#define PG8_LDB(dst, b, h) do { _Pragma("unroll") for (int n = 0; n < 2; ++n) _Pragma("unroll") for (int k = 0; k < 2; ++k) dst[n][k] = *(const PG8_LAS bf16x8*)(lds + PG8_SB(b, h) + boff + n * 2048 + k * 1024); } while (0)
#define PG8_MMA(ai, bj, At, Bt) do { __builtin_amdgcn_s_setprio(1); _Pragma("unroll") for (int m = 0; m < 4; ++m) _Pragma("unroll") for (int n = 0; n < 2; ++n) _Pragma("unroll") for (int k = 0; k < 2; ++k) \
        acc[ai][bj][m][n] = __builtin_amdgcn_mfma_f32_16x16x32_bf16(Bt[n][k], At[m][k], acc[ai][bj][m][n], 0, 0, 0); __builtin_amdgcn_s_setprio(0); } while (0)
#define PG8_WAIT_V(n) asm volatile("s_waitcnt vmcnt(" #n ")" ::: "memory")
#define PG8_WAIT_L(n) asm volatile("s_waitcnt lgkmcnt(" #n ")" ::: "memory")
#define PG8_BAR __builtin_amdgcn_s_barrier()
#define PG8_SCHED __builtin_amdgcn_sched_barrier(0)
    Unit cur, nxt; int ui = 0;
    if (!S.next(0, cur)) return;
    f32x4 acc[2][2][4][2];
#pragma unroll
    for (int a = 0; a < 2; ++a)
#pragma unroll
        for (int b = 0; b < 2; ++b)
#pragma unroll
            for (int m = 0; m < 4; ++m)
#pragma unroll
                for (int n = 0; n < 2; ++n) acc[a][b][m][n] = (f32x4){0.f, 0.f, 0.f, 0.f};
    bf16x8 At[4][2], B0[2][2], B1[2][2];
    const char* cA = (const char*)g.A + (size_t)cur.pm * tstep; const char* cB = (const char*)g.Bt + (size_t)cur.pn * tstep;
    S.a_ready(cur);
    if constexpr (SP2) {
        PG8_STAGE(PG8_SB(0, 0), cB, voffB); PG8_STAGE(PG8_SB(0, 1), cB + hstep, voffB); PG8_STAGE(PG8_SA(0, 0), cA, voffA); PG8_STAGE(PG8_SA(0, 1), cA + hstep, voffA);
        if (wr == 1) PG8_BAR;
        PG8_WAIT_V(2); PG8_BAR;
        PG8_STAGE(PG8_SB(1, 0), cB + kstep, voffB); PG8_STAGE(PG8_SA(1, 0), cA + kstep, voffA); PG8_STAGE(PG8_SB(1, 1), cB + hstep + kstep, voffB);
        PG8_WAIT_V(6); PG8_BAR;
    } else {
        PG8_STAGE(PG8_SB(0, 0), cB, voffB); PG8_STAGE(PG8_SA(0, 0), cA, voffA); PG8_STAGE(PG8_SB(0, 1), cB + hstep, voffB); PG8_STAGE(PG8_SA(0, 1), cA + hstep, voffA);
        if (wr == 1) PG8_BAR;
        PG8_WAIT_V(4); PG8_BAR;
        PG8_STAGE(PG8_SB(1, 0), cB + kstep, voffB); PG8_STAGE(PG8_SA(1, 0), cA + kstep, voffA); PG8_STAGE(PG8_SB(1, 1), cB + hstep + kstep, voffB);
        PG8_WAIT_V(6); PG8_BAR;
    }
    for (;;) {
        const bool has_next = S.next(ui + 1, nxt);
        const char* nA = has_next ? (const char*)g.A + (size_t)nxt.pm * tstep : cA; const char* nB = has_next ? (const char*)g.Bt + (size_t)nxt.pn * tstep : cB;
        for (int t = 0; t < nt; t += 2) {
            const bool last = (t == nt - 2);
            const char* a1 = cA + (size_t)(t + 1) * kstep;
            const char* a2 = last ? nA : cA + (size_t)(t + 2) * kstep; const char* b2 = last ? nB : cB + (size_t)(t + 2) * kstep;
            const char* a3 = a2 + kstep; const char* b3 = b2 + kstep;
            if (last && has_next) S.a_ready(nxt);
            if constexpr (SP2) {
            PG8_LDB(B0, 0, 0); PG8_LDB(B1, 0, 1); PG8_SCHED; PG8_LDA(At, 0, 0); PG8_STAGE(PG8_SA(1, 1), a1 + hstep, voffA);
            PG8_WAIT_V(8); PG8_WAIT_L(0); PG8_BAR; PG8_MMA(0, 0, At, B0); PG8_MMA(0, 1, At, B1); PG8_BAR; PG8_SCHED;
            PG8_LDA(At, 0, 1); PG8_STAGE(PG8_SB(0, 0), b2, voffB); PG8_STAGE(PG8_SB(0, 1), b2 + hstep, voffB); PG8_STAGE(PG8_SA(0, 0), a2, voffA);
            PG8_WAIT_V(8); PG8_WAIT_L(0); PG8_BAR; PG8_MMA(1, 0, At, B0); PG8_MMA(1, 1, At, B1); PG8_BAR; PG8_SCHED;
            PG8_LDB(B0, 1, 0); PG8_LDB(B1, 1, 1); PG8_SCHED; PG8_LDA(At, 1, 0); PG8_STAGE(PG8_SA(0, 1), a2 + hstep, voffA);
            PG8_WAIT_V(8); PG8_WAIT_L(0); PG8_BAR; PG8_MMA(0, 0, At, B0); PG8_MMA(0, 1, At, B1); PG8_BAR; PG8_SCHED;
            PG8_LDA(At, 1, 1); PG8_STAGE(PG8_SB(1, 0), b3, voffB); PG8_STAGE(PG8_SB(1, 1), b3 + hstep, voffB); PG8_STAGE(PG8_SA(1, 0), a3, voffA);
            PG8_WAIT_V(8); PG8_WAIT_L(0); PG8_BAR; PG8_MMA(1, 0, At, B0); PG8_MMA(1, 1, At, B1); PG8_BAR; PG8_SCHED;
            } else {
            PG8_LDB(B0, 0, 0); PG8_SCHED; PG8_LDA(At, 0, 0); PG8_STAGE(PG8_SA(1, 1), a1 + hstep, voffA);
            PG8_WAIT_L(8); PG8_BAR; PG8_WAIT_L(0); PG8_MMA(0, 0, At, B0); PG8_BAR; PG8_SCHED;
            PG8_LDB(B1, 0, 1); PG8_STAGE(PG8_SB(0, 0), b2, voffB);
            PG8_BAR; PG8_WAIT_L(0); PG8_MMA(0, 1, At, B1); PG8_BAR;
            PG8_LDA(At, 0, 1); PG8_STAGE(PG8_SA(0, 0), a2, voffA);
            PG8_BAR; PG8_WAIT_L(0); PG8_MMA(1, 0, At, B0); PG8_BAR; PG8_SCHED;
            PG8_STAGE(PG8_SB(0, 1), b2 + hstep, voffB);
            PG8_WAIT_V(6); PG8_BAR; PG8_MMA(1, 1, At, B1); PG8_BAR;
            PG8_LDB(B0, 1, 0); PG8_SCHED; PG8_LDA(At, 1, 0); PG8_STAGE(PG8_SA(0, 1), a2 + hstep, voffA);
            PG8_WAIT_L(8); PG8_BAR; PG8_WAIT_L(0); PG8_MMA(0, 0, At, B0); PG8_BAR; PG8_SCHED;
            PG8_LDB(B1, 1, 1); PG8_STAGE(PG8_SB(1, 0), b3, voffB);
            PG8_BAR; PG8_WAIT_L(0); PG8_MMA(0, 1, At, B1); PG8_BAR;
            PG8_LDA(At, 1, 1); PG8_STAGE(PG8_SA(1, 0), a3, voffA);
            PG8_BAR; PG8_WAIT_L(0); PG8_MMA(1, 0, At, B0); PG8_BAR; PG8_SCHED;
            PG8_STAGE(PG8_SB(1, 1), b3 + hstep, voffB);
            PG8_WAIT_V(6); PG8_BAR; PG8_MMA(1, 1, At, B1); PG8_BAR;
            }
        }
        if constexpr (ALIGN_EPI) { if (wr == 0) PG8_BAR; }
        if constexpr (!Epi::AFTER_DRAIN) { E(acc, cur, wr, wc, fr, fq); S.done(cur); }
        if (!has_next) break;
#pragma unroll
        for (int a = 0; a < 2; ++a)
#pragma unroll
            for (int b = 0; b < 2; ++b)
#pragma unroll
                for (int m = 0; m < 4; ++m)
#pragma unroll
                    for (int n = 0; n < 2; ++n) acc[a][b][m][n] = (f32x4){0.f, 0.f, 0.f, 0.f};
        cur = nxt; cA = nA; cB = nB; ++ui;
        if constexpr (ALIGN_EPI) { if (wr == 1) PG8_BAR; }
    }
    PG8_WAIT_V(0);
    if constexpr (!ALIGN_EPI) { if (wr == 0) PG8_BAR; }
    PG8_BAR;
    if constexpr (Epi::AFTER_DRAIN) { E.fused(acc, cur, wr, wc, fr, fq, lds, wid, lane); S.done(cur); }
#undef PG8_SA
#undef PG8_SB
#undef PG8_STAGE
#undef PG8_LDA
#undef PG8_LDB
#undef PG8_MMA
#undef PG8_WAIT_V
#undef PG8_WAIT_L
#undef PG8_BAR
#undef PG8_SCHED
}
}
#ifndef PG8_SP2
#define PG8_SP2 true
#endif
#ifndef PG8_ALIGN
#define PG8_ALIGN true
#endif

constexpr int NWAVES = 8;
#ifndef MK_N_LAUNCHES
#define MK_N_LAUNCHES 1
#endif
constexpr int N_LAUNCHES = MK_N_LAUNCHES;
constexpr int N_PHASES = 8;

using pg8::MP; using pg8::MS; using pg8::MALL; using pg8::NVALID;
using pg8::O_YP; using pg8::O_YS; using pg8::O_KVP; using pg8::O_WINP; using pg8::O_CONVP; using pg8::O_KVS; using pg8::O_WINS; using pg8::O_CONVS; using pg8::O_END;
constexpr int D = 1024, SEQ = 2048, NB = 8, CC = 512, FF = 4096, NIN = 2328, NINP = 2560, NPHYS = 2560;
constexpr float RMS_EPS = 1e-6f, LN_EPS = 1e-5f;

constexpr size_t MiB = 1u << 20;
constexpr size_t WS_CTL = 0, CTL_ZERO_BYTES = 2 * MiB;
constexpr size_t WS_SS1 = 256 * 1024, WS_SS2 = 384 * 1024, WS_DACC = 1 * MiB;
constexpr size_t WS_WIN = 2 * MiB, WS_WOUT = 7 * MiB, WS_WUP = 9 * MiB, WS_WDN = 17 * MiB;
constexpr size_t WS_XN = 26 * MiB, WS_G = 59 * MiB, WS_Q = 76 * MiB, WS_KV = 93 * MiB, WS_GATE = 118 * MiB;
constexpr size_t WS_KCP = 121 * MiB, WS_VCP = 121 * MiB + 256 * 1024, WS_KCVS = 122 * MiB;
constexpr size_t WS_AO = 130 * MiB, WS_HB = 163 * MiB, WS_MID = 196 * MiB, WS_END = 327 * MiB;
static_assert(WS_XN + (size_t)MALL * D * 2 <= WS_G && WS_G + (size_t)MALL * CC * 2 <= WS_Q && WS_Q + (size_t)MALL * 512 * 2 <= WS_KV && WS_KV + (size_t)MALL * 768 * 2 <= WS_GATE &&
              WS_GATE + (size_t)MALL * 32 * 4 <= WS_KCP && WS_KCVS + (size_t)MS * 64 * 256 * 4 <= WS_AO && WS_AO + (size_t)MALL * D * 2 <= WS_HB && WS_HB + (size_t)MALL * D * 2 <= WS_MID &&
              WS_MID + (size_t)MALL * FF * 2 <= WS_END, "d_ws map");
constexpr int CW_TMO = 0, CW_QUEUE = 64;
constexpr int CW_BAR = 4096;

constexpr int RING_OFF = 0, RING_BYTES = 131072;
constexpr int LDSCTL_OFF = RING_BYTES, MISC_OFF = LDSCTL_OFF + 320;
constexpr int LDS_BYTES = 147456;

#define GAS __attribute__((address_space(1)))
#define LAS __attribute__((address_space(3)))
typedef unsigned short bf16;
typedef unsigned v4u __attribute__((ext_vector_type(4)));
typedef float f32x4 __attribute__((ext_vector_type(4)));
typedef short bf16x8 __attribute__((ext_vector_type(8)));
typedef GAS unsigned gu32;
typedef GAS unsigned long long gu64;
#define RLX_AGENT __ATOMIC_RELAXED, __HIP_MEMORY_SCOPE_AGENT
#define LDS_WAIT() asm volatile("s_waitcnt lgkmcnt(0)" ::: "memory")
#define VM_WAIT() asm volatile("s_waitcnt vmcnt(0)" ::: "memory")
__device__ __forceinline__ unsigned long long rt() { return __builtin_amdgcn_s_memrealtime(); }
__device__ __forceinline__ unsigned f2bf(float f) { unsigned u = __builtin_bit_cast(unsigned, f); return (u + 0x7fffu + ((u >> 16) & 1u)) >> 16; }
__device__ __forceinline__ unsigned pk2(float lo, float hi) { return f2bf(lo) | (f2bf(hi) << 16); }

#define XB_TMO      128
#define XB_XCNT(j)  (256  + 64 * (j))
#define XB_XSUB(j)  (1280 + 64 * (j))
#define XB_XGEN(j)  (2304 + 64 * (j))
#define XB_TOP      3328
#define XB_TOPGEN   3392
#define XCD_BAR_WORDS 3456
#define XB_SPIN_CAP (1u << 18)

__device__ __forceinline__ unsigned xb_ld(unsigned* p)              { return __hip_atomic_load(p, __ATOMIC_RELAXED, __HIP_MEMORY_SCOPE_AGENT); }
__device__ __forceinline__ unsigned xb_add(unsigned* p, unsigned v) { return __hip_atomic_fetch_add(p, v, __ATOMIC_RELAXED, __HIP_MEMORY_SCOPE_AGENT); }
__device__ __forceinline__ unsigned xb_xcc_id() { return (unsigned)__builtin_amdgcn_s_getreg((3 << 11) | 20) & 0xFu; }
#define XB_SPIN(cond, bar) do { unsigned _sp = 0; while (cond) { __builtin_amdgcn_s_sleep(1); \
    if ((++_sp & 255u) == 0u) { if (xb_ld(&(bar)[XB_TMO])) break; if (_sp > XB_SPIN_CAP) { atomicAdd(&(bar)[XB_TMO], 1u); break; } } } } while (0)

struct XcdBarrier {
    unsigned* bar; unsigned x;
    volatile LAS unsigned* st;
};

__device__ __forceinline__ XcdBarrier xcd_barrier_post(unsigned* bar, volatile LAS unsigned* st) {
    XcdBarrier b; b.bar = bar; b.x = xb_xcc_id(); b.st = st;
    if (threadIdx.x == 0) (void)xb_add(&bar[XB_XCNT(b.x)], 1u);
    return b;
}
__device__ __forceinline__ void xcd_barrier_complete(unsigned* bar, unsigned x, unsigned& nloc, unsigned& nx) {
    const unsigned G = gridDim.x * gridDim.y * gridDim.z;
    unsigned sum, cnt, mine, sp = 0u;
    for (;;) {
        sum = 0u; cnt = 0u; mine = 0u;
#pragma unroll
        for (unsigned j = 0; j < 16; ++j) { const unsigned c = xb_ld(&bar[XB_XCNT(j)]); sum += c; cnt += (c > 0u) ? 1u : 0u; mine = (j == x) ? c : mine; }
        if (sum == G) break;
        __builtin_amdgcn_s_sleep(1);
        if ((++sp & 255u) == 0u) { if (xb_ld(&bar[XB_TMO])) break; if (sp > XB_SPIN_CAP) { atomicAdd(&bar[XB_TMO], 1u); break; } }
    }
    nloc = mine > 0u ? mine : 1u; nx = cnt > 0u ? cnt : 1u;
}

__device__ __forceinline__ void xcd_barrier(const XcdBarrier& b) {
    asm volatile("s_waitcnt vmcnt(0)" ::: "memory");
    __syncthreads();
    if (threadIdx.x == 0) {
        unsigned* bar = b.bar;
        __builtin_amdgcn_s_waitcnt(0);
        unsigned nloc = b.st[0], nx = b.st[1];
        if (nloc == 0u) { xcd_barrier_complete(bar, b.x, nloc, nx); b.st[0] = nloc; b.st[1] = nx; }
        const unsigned old = xb_add(&bar[XB_XSUB(b.x)], 1u);
        const unsigned gen = old / nloc;
        if (old + 1u == (gen + 1u) * nloc) {
            __builtin_amdgcn_fence(__ATOMIC_RELEASE, "agent");
            asm volatile("s_waitcnt vmcnt(0)" ::: "memory");
            const unsigned og = xb_add(&bar[XB_TOP], 1u);
            const unsigned tg = og / nx;
            if (og + 1u == (tg + 1u) * nx) xb_add(&bar[XB_TOPGEN], 1u);
            else XB_SPIN(xb_ld(&bar[XB_TOPGEN]) == tg, bar);
            __builtin_amdgcn_fence(__ATOMIC_ACQUIRE, "agent");
            xb_add(&bar[XB_XGEN(b.x)], 1u);
            asm volatile("s_waitcnt vmcnt(0)" ::: "memory");
        } else {
            XB_SPIN(xb_ld(&bar[XB_XGEN(b.x)]) == gen, bar);
            __builtin_amdgcn_fence(__ATOMIC_ACQUIRE, "agent");
            asm volatile("s_waitcnt vmcnt(0)" ::: "memory");
        }
    }
    __syncthreads();
}

typedef const __attribute__((address_space(4))) unsigned char* kptr_t;
struct Frame {
    LAS unsigned char* lds;
    volatile LAS unsigned* MISC;
    kptr_t ka;
    gu32* ctl;
    int tid, lane, wave;
    int vcu, G;
    const float *x_prompt, *x_sample, *cache_kv, *cache_win, *state_conv; const int* page_table;
    const float *g_attn, *w_in, *w_dw, *b_dw, *ln_g, *ln_b, *w_ck, *w_cv, *w_out, *g_mlp, *w_up, *w_down, *g_final;
    float* out;
    bf16 *Win_t, *Wout_t, *Wup_t, *Wdn_t, *XN, *Gb, *Qb, *KVb, *KCP, *VCP, *AO, *HB, *MID;
    float *GATE, *KCVS, *SS1, *SS2, *DACC;
};

__device__ __forceinline__ void frame_fill(Frame& F) {
    kptr_t ka = F.ka; asm volatile("" : "+s"(ka));
    typedef const void* const __attribute__((address_space(4)))* kpp_t;
    kpp_t in = (kpp_t)ka;
    F.x_prompt = (const float*)in[0]; F.x_sample = (const float*)in[1]; F.cache_kv = (const float*)in[2]; F.cache_win = (const float*)in[3];
    F.state_conv = (const float*)in[4]; F.page_table = (const int*)in[5]; F.g_attn = (const float*)in[6]; F.w_in = (const float*)in[7];
    F.w_dw = (const float*)in[8]; F.b_dw = (const float*)in[9]; F.ln_g = (const float*)in[10]; F.ln_b = (const float*)in[11];
    F.w_ck = (const float*)in[12]; F.w_cv = (const float*)in[13]; F.w_out = (const float*)in[14]; F.g_mlp = (const float*)in[15];
    F.w_up = (const float*)in[16]; F.w_down = (const float*)in[17]; F.g_final = (const float*)in[18];
    F.out = (float*)in[19];
    unsigned char* ws = (unsigned char*)in[20];
    F.ctl = (gu32*)(ws + WS_CTL);
    F.Win_t = (bf16*)(ws + WS_WIN); F.Wout_t = (bf16*)(ws + WS_WOUT); F.Wup_t = (bf16*)(ws + WS_WUP); F.Wdn_t = (bf16*)(ws + WS_WDN);
    F.XN = (bf16*)(ws + WS_XN); F.Gb = (bf16*)(ws + WS_G); F.Qb = (bf16*)(ws + WS_Q); F.KVb = (bf16*)(ws + WS_KV); F.GATE = (float*)(ws + WS_GATE);
    F.KCP = (bf16*)(ws + WS_KCP); F.VCP = (bf16*)(ws + WS_VCP); F.KCVS = (float*)(ws + WS_KCVS);
    F.AO = (bf16*)(ws + WS_AO); F.HB = (bf16*)(ws + WS_HB); F.MID = (bf16*)(ws + WS_MID);
    F.SS1 = (float*)(ws + WS_SS1); F.SS2 = (float*)(ws + WS_SS2); F.DACC = (float*)(ws + WS_DACC);
}
__device__ __forceinline__ float wave_sum(float v) {
#pragma unroll
    for (int o = 1; o < 64; o <<= 1) v += __shfl_xor(v, o);
    return v;
}
__device__ __forceinline__ float sigmoidf_(float x) { return __builtin_amdgcn_rcpf(1.0f + __builtin_amdgcn_exp2f(-1.4426950408889634f * x)); }
__device__ __forceinline__ float bf2f(unsigned short b) { return __uint_as_float((unsigned)b << 16); }

__device__ __forceinline__ void p0_transpose_item(const float* W, int K, int N, bf16* WT, int k0, int n0, int drow0, LAS float* scr, int lane) {
#pragma unroll 8
    for (int i = 0; i < 32; ++i) { const int kk = 2 * i + (lane >> 5); const int n = n0 + (lane & 31); scr[kk * 33 + (lane & 31)] = (n < N) ? W[(size_t)(k0 + kk) * N + n] : 0.f; }
    LDS_WAIT(); asm volatile("" ::: "memory");
    const int c = lane & 7;
#pragma unroll
    for (int j = 0; j < 4; ++j) { const int n = (lane >> 3) + 8 * j; const LAS float* s = scr + (8 * c) * 33 + n;
        v4u o; o.x = pk2(s[0 * 33], s[1 * 33]); o.y = pk2(s[2 * 33], s[3 * 33]); o.z = pk2(s[4 * 33], s[5 * 33]); o.w = pk2(s[6 * 33], s[7 * 33]);
        *(GAS v4u*)(WT + (size_t)(drow0 + n) * K + k0 + 8 * c) = o; }
    LDS_WAIT(); asm volatile("" ::: "memory");
}
__device__ __forceinline__ int win_row(int n) { if (n < 512) return 256 * (n >> 7) + (n & 127); if (n < 1024) { const int c = n - 512; return 256 * (c >> 7) + 128 + (c & 127); } return n; }

__device__ __forceinline__ void rms_row_to_bf16(const float* xrow, const float* g, bf16* orow, int lane) {
    const GAS f32x4* xr = (const GAS f32x4*)xrow + lane; const GAS f32x4* gr = (const GAS f32x4*)g + lane;
    f32x4 v[4]; float s = 0.f;
#pragma unroll
    for (int j = 0; j < 4; ++j) { v[j] = xr[64 * j]; s += (v[j].x * v[j].x + v[j].y * v[j].y) + (v[j].z * v[j].z + v[j].w * v[j].w); }
    const float r = 1.0f / sqrtf(wave_sum(s) * (1.f / 1024.f) + RMS_EPS);
    GAS unsigned long long* o8 = (GAS unsigned long long*)orow + lane;
#pragma unroll
    for (int j = 0; j < 4; ++j) { const f32x4 gg = gr[64 * j]; o8[64 * j] = (unsigned long long)pk2(v[j].x * r * gg.x, v[j].y * r * gg.y) | ((unsigned long long)pk2(v[j].z * r * gg.z, v[j].w * r * gg.w) << 32); }
}
__device__ __forceinline__ void spool_item(Frame& F, int item) {
    const int bs = item >> 6, c = item & 63, lane = F.lane;
    const int page = F.page_table[bs * 16 + (c >> 2)], row0 = (c & 3) * 32;
    const float* src = F.cache_kv + ((size_t)page * 128 + row0) * 512 + lane * 4;
    const float* w = (lane < 32 ? F.w_ck : F.w_cv) + ((lane >> 4) & 1);
    f32x4 acc = (f32x4){0.f, 0.f, 0.f, 0.f};
#pragma unroll
    for (int hlf = 0; hlf < 2; ++hlf) {
        f32x4 v[16]; float wj[16];
#pragma unroll
        for (int j = 0; j < 16; ++j) { v[j] = __builtin_nontemporal_load((const f32x4*)(src + (size_t)(hlf * 16 + j) * 512)); wj[j] = w[(hlf * 16 + j) * 2]; }
#pragma unroll
        for (int j = 0; j < 16; ++j) acc += v[j] * wj[j];
    }
    *(f32x4*)(F.KCVS + ((size_t)bs * 64 + c) * 256 + lane * 4) = acc;
}
__device__ __forceinline__ void p0_prologue(Frame& F) {
    LAS float* scr = (LAS float*)(F.lds + RING_OFF + F.wave * 16384);
    const int gw = F.vcu * NWAVES + F.wave, NGW = F.G * NWAVES;
    constexpr int NB_IN = 73;
    constexpr int I_IN = (D / 64) * NB_IN, I_OUT = (D / 64) * (D / 32), I_UP = (D / 64) * (FF / 32), I_DN = (FF / 64) * (D / 32);
    constexpr int NITEMS = I_IN + I_OUT + I_UP + I_DN;
    for (int it = gw; it < NITEMS; it += NGW) {
        int r = it;
        if (r < I_IN) { const int kb = r / NB_IN, nb = r % NB_IN; p0_transpose_item(F.w_in, D, NIN, F.Win_t, 64 * kb, 32 * nb, win_row(32 * nb), scr, F.lane); continue; } r -= I_IN;
        if (r < I_OUT) { const int kb = r / (D / 32), nb = r % (D / 32); p0_transpose_item(F.w_out, D, D, F.Wout_t, 64 * kb, 32 * nb, 32 * nb, scr, F.lane); continue; } r -= I_OUT;
        if (r < I_UP) { const int kb = r / (FF / 32), nb = r % (FF / 32); p0_transpose_item(F.w_up, D, FF, F.Wup_t, 64 * kb, 32 * nb, 32 * nb, scr, F.lane); continue; } r -= I_UP;
        { const int kb = r / (D / 32), nb = r % (D / 32); p0_transpose_item(F.w_down, FF, D, F.Wdn_t, 64 * kb, 32 * nb, 32 * nb, scr, F.lane); }
    }
    for (int rr = gw; rr < NINP - 2336; rr += NGW) { GAS v4u* o = (GAS v4u*)(F.Win_t + (size_t)(2336 + rr) * D) + F.lane; o[0] = (v4u){0u, 0u, 0u, 0u}; o[64] = (v4u){0u, 0u, 0u, 0u}; }
    for (int m = gw; m < MALL; m += NGW) {
        if (m < MP) rms_row_to_bf16(F.x_prompt + (size_t)m * D, F.g_attn, F.XN + (size_t)m * D, F.lane);
        else if (m < NVALID) rms_row_to_bf16(F.x_sample + (size_t)(m - MP) * D, F.g_attn, F.XN + (size_t)m * D, F.lane);
        else { GAS v4u* o = (GAS v4u*)(F.XN + (size_t)m * D) + F.lane; o[0] = (v4u){0u, 0u, 0u, 0u}; o[64] = (v4u){0u, 0u, 0u, 0u}; }
    }
    for (int it = gw; it < MS * 64; it += NGW) spool_item(F, it);
}

__device__ __forceinline__ void conv_unit(Frame& F, int unit) {
    const int b = unit >> 6, t0 = (unit & 63) * 32, tg = F.wave >> 2, cq = F.wave & 3, lane = F.lane;
    const int ch = cq * 128 + 2 * lane, tbase = t0 + 16 * tg;
    float w0[31], w1[31];
#pragma unroll
    for (int j = 0; j < 31; ++j) { const float2 wv = *(const float2*)(F.w_dw + j * 512 + ch); w0[j] = wv.x; w1[j] = wv.y; }
    unsigned xr[46];
#pragma unroll
    for (int r = 0; r < 46; ++r) { const int tr = tbase - 30 + r; const int trc = tr < 0 ? 0 : tr; xr[r] = *(const unsigned*)(F.Gb + ((size_t)(b * SEQ + trc)) * 512 + ch); }
#pragma unroll
    for (int r = 0; r < 30; ++r) { if (tbase - 30 + r < 0) xr[r] = 0u; }
    const float2 bd = *(const float2*)(F.b_dw + ch);
    float a0[16], a1[16];
#pragma unroll
    for (int i = 0; i < 16; ++i) { a0[i] = bd.x; a1[i] = bd.y; }
#pragma unroll
    for (int r = 0; r < 46; ++r) { const float x0 = __uint_as_float(xr[r] << 16), x1 = __uint_as_float(xr[r] & 0xffff0000u);
#pragma unroll
        for (int i = 0; i < 16; ++i) { const int j = r - i; if (j >= 0 && j <= 30) { a0[i] += x0 * w0[j]; a1[i] += x1 * w1[j]; } } }
    typedef float f32x2v __attribute__((ext_vector_type(2)));
    LAS f32x2v* RED = (LAS f32x2v*)(F.lds + RING_OFF);
    LAS f32x2v* STAT = (LAS f32x2v*)(F.lds + RING_OFF + 73728);
#pragma unroll
    for (int i = 0; i < 16; ++i) RED[(tg * 16 + i) * 272 + cq * 64 + lane] = (f32x2v){a0[i] + a1[i], a0[i] * a0[i] + a1[i] * a1[i]};
    __syncthreads();
    { const int tk = F.tid >> 4, p = F.tid & 15; float s = 0.f, q = 0.f;
#pragma unroll
      for (int e = 0; e < 16; ++e) { const f32x2v v = RED[tk * 272 + e * 16 + p]; s += v.x; q += v.y; }
#pragma unroll
      for (int o = 1; o < 16; o <<= 1) { s += __shfl_xor(s, o); q += __shfl_xor(q, o); }
      if (p == 0) { const float mu = s * (1.f / 512.f); const float var = fmaxf(q * (1.f / 512.f) - mu * mu, 0.f); STAT[tk] = (f32x2v){mu, 1.0f / sqrtf(var + LN_EPS)}; } }
    __syncthreads();
    const float2 lg = *(const float2*)(F.ln_g + ch), lb = *(const float2*)(F.ln_b + ch);
#pragma unroll
    for (int i = 0; i < 16; ++i) { const f32x2v st = STAT[tg * 16 + i];
        const float y0 = (a0[i] - st.x) * st.y * lg.x + lb.x, y1 = (a1[i] - st.x) * st.y * lg.y + lb.y;
        *(unsigned*)(F.AO + ((size_t)(b * SEQ + tbase + i)) * D + ch) = pk2(y0 * sigmoidf_(y0), y1 * sigmoidf_(y1)); }
    __syncthreads();
}
__device__ __forceinline__ void sconv_unit(Frame& F, int bs) {
    const int c = F.tid;
    const float* st = F.state_conv + (size_t)bs * 30 * 512 + c;
    float* oc = F.out + O_CONVS + (size_t)bs * 30 * 512 + c;
    float sv[31], wv[31];
#pragma unroll
    for (int j = 0; j < 30; ++j) sv[j] = st[j * 512];
    sv[30] = oc[29 * 512];
#pragma unroll
    for (int j = 0; j < 31; ++j) wv[j] = F.w_dw[j * 512 + c];
    float a = F.b_dw[c];
#pragma unroll
    for (int j = 0; j < 31; ++j) a += sv[j] * wv[j];
#pragma unroll
    for (int j = 1; j < 30; ++j) oc[(j - 1) * 512] = sv[j];
    LAS float* RS = (LAS float*)(F.lds + RING_OFF);
    const float s = wave_sum(a), q = wave_sum(a * a);
    if (F.lane == 0) { RS[F.wave] = s; RS[8 + F.wave] = q; }
    __syncthreads();
    float ts = 0.f, tq = 0.f;
#pragma unroll
    for (int w = 0; w < 8; ++w) { ts += RS[w]; tq += RS[8 + w]; }
    const float mu = ts * (1.f / 512.f); const float var = fmaxf(tq * (1.f / 512.f) - mu * mu, 0.f); const float rstd = 1.0f / sqrtf(var + LN_EPS);
    const float y = (a - mu) * rstd * F.ln_g[c] + F.ln_b[c];
    F.AO[(size_t)(MP + bs) * D + c] = (bf16)f2bf(y * sigmoidf_(y));
    __syncthreads();
}
__device__ __forceinline__ void ppool_item(Frame& F, int item) {
    const int b = item >> 6, c = item & 63, lane = F.lane;
    const bf16* src = F.KVb + ((size_t)(b * SEQ + c * 32)) * 768 + lane * 4;
    const float* w = (lane < 32 ? F.w_ck : F.w_cv) + ((lane >> 4) & 1);
    float a[4] = {0.f, 0.f, 0.f, 0.f};
    unsigned long long vv[32];
#pragma unroll
    for (int j = 0; j < 32; ++j) vv[j] = *(const unsigned long long*)(src + (size_t)j * 768);
#pragma unroll
    for (int j = 0; j < 32; ++j) { const unsigned long long v = vv[j]; const float wj = w[j * 2];
        a[0] += bf2f((unsigned short)v) * wj; a[1] += bf2f((unsigned short)(v >> 16)) * wj; a[2] += bf2f((unsigned short)(v >> 32)) * wj; a[3] += bf2f((unsigned short)(v >> 48)) * wj; }
    const int h = (lane >> 4) & 1, d = (lane & 15) * 4;
    bf16* dst = (lane < 32 ? F.KCP : F.VCP) + ((size_t)((b * 2 + h) * 64 + c)) * 64 + d;
    *(unsigned long long*)dst = (unsigned long long)pk2(a[0], a[1]) | ((unsigned long long)pk2(a[2], a[3]) << 32);
}
__device__ __forceinline__ void p2_phase(Frame& F) {
    if (F.wave < 2) { for (int it = F.vcu * 2 + F.wave; it < NB * 64; it += F.G * 2) ppool_item(F, it); }
    for (int u = F.vcu; u < MS; u += F.G) sconv_unit(F, u);
    for (int u = F.G - 1 - F.vcu; u < MP / 32; u += F.G) conv_unit(F, u);
}

__device__ __forceinline__ pg8::f32x4 skinny_tile(LAS unsigned char* lds, const bf16* A, int lda, const bf16* Bt, int ldb, int n0, int k0, int wave, int lane) {
    const bf16* ap = A + (size_t)(lane & 15) * lda + k0 + 128 * wave + 8 * (lane >> 4);
    const bf16* bp = Bt + (size_t)(n0 + (lane & 15)) * ldb + k0 + 128 * wave + 8 * (lane >> 4);
    bf16x8 b[4], a[8][4];
#pragma unroll
    for (int s = 0; s < 4; ++s) b[s] = *(const bf16x8*)(bp + s * 32);
#pragma unroll
    for (int rb = 0; rb < 8; ++rb)
#pragma unroll
        for (int s = 0; s < 4; ++s) a[rb][s] = *(const bf16x8*)(ap + (size_t)(16 * rb) * lda + s * 32);
    LAS pg8::f32x4* RED = (LAS pg8::f32x4*)lds;
#pragma unroll
    for (int rb = 0; rb < 8; ++rb) { pg8::f32x4 acc = (pg8::f32x4){0.f, 0.f, 0.f, 0.f};
#pragma unroll
        for (int s = 0; s < 4; ++s) acc = __builtin_amdgcn_mfma_f32_16x16x32_bf16(a[rb][s], b[s], acc, 0, 0, 0);
        RED[(wave * 8 + rb) * 64 + lane] = acc; }
    __syncthreads();
    pg8::f32x4 r = RED[wave * 64 + lane];
#pragma unroll
    for (int w = 1; w < 8; ++w) r += RED[(w * 8 + wave) * 64 + lane];
    __syncthreads();
    return r;
}
__device__ __forceinline__ void s_outproj_item(Frame& F, int item) {
    const int n0 = item * 16, lane = F.lane, col = n0 + (lane & 15);
    const pg8::f32x4 acc = skinny_tile(F.lds + RING_OFF, F.AO + (size_t)MP * D, D, F.Wout_t, D, n0, 0, F.wave, lane);
    const float g = F.g_mlp[col];
#pragma unroll
    for (int i = 0; i < 4; ++i) { const int row = 16 * F.wave + 4 * (lane >> 4) + i; const float hv = F.x_sample[(size_t)row * D + col] + acc[i];
        F.out[O_YS + (size_t)row * D + col] = hv; F.HB[(size_t)(MP + row) * D + col] = (bf16)f2bf(hv * g);
        float s = hv * hv; s += __shfl_xor(s, 1); s += __shfl_xor(s, 2); s += __shfl_xor(s, 4); s += __shfl_xor(s, 8);
        if ((lane & 15) == 0) atomicAdd(F.SS1 + MP + row, s); }
}
__device__ __forceinline__ void s_up_item(Frame& F, int item) {
    const int n0 = item * 16, lane = F.lane, col = n0 + (lane & 15);
    const pg8::f32x4 acc = skinny_tile(F.lds + RING_OFF, F.HB + (size_t)MP * D, D, F.Wup_t, D, n0, 0, F.wave, lane);
#pragma unroll
    for (int i = 0; i < 4; ++i) { const int row = 16 * F.wave + 4 * (lane >> 4) + i; const float r = __builtin_amdgcn_rsqf(F.SS1[MP + row] * (1.f / 1024.f) + RMS_EPS);
        const float v = fmaxf(acc[i] * r, 0.f); F.MID[(size_t)(MP + row) * FF + col] = (bf16)f2bf(v * v); }
}
__device__ __forceinline__ void s_down_item(Frame& F, int item) {
    const int n0 = (item & 63) * 16, kq = item >> 6, lane = F.lane, col = n0 + (lane & 15);
    const pg8::f32x4 acc = skinny_tile(F.lds + RING_OFF, F.MID + (size_t)MP * FF, FF, F.Wdn_t, FF, n0, kq * 1024, F.wave, lane);
#pragma unroll
    for (int i = 0; i < 4; ++i) { const int row = 16 * F.wave + 4 * (lane >> 4) + i; atomicAdd(F.DACC + (size_t)row * D + col, acc[i]); }
}
__device__ __forceinline__ void p7_phase(Frame& F, float* ydst_p, float* ydst_s) {
    const int gw = F.vcu * NWAVES + F.wave, NGW = F.G * NWAVES, lane = F.lane;
    const GAS f32x4* gr = (const GAS f32x4*)F.g_final + lane;
    f32x4 gg[4];
#pragma unroll
    for (int j = 0; j < 4; ++j) gg[j] = gr[64 * j];
    for (int m = gw; m < MS; m += NGW) {
        GAS f32x4* yr = (GAS f32x4*)(F.out + O_YS + (size_t)m * D) + lane; const GAS f32x4* dr = (const GAS f32x4*)(F.DACC + (size_t)m * D) + lane;
        f32x4 v[4]; float s = 0.f;
#pragma unroll
        for (int j = 0; j < 4; ++j) { v[j] = yr[64 * j] + dr[64 * j]; s += (v[j].x * v[j].x + v[j].y * v[j].y) + (v[j].z * v[j].z + v[j].w * v[j].w); }
        const float r = 1.0f / sqrtf(wave_sum(s) * (1.f / 1024.f) + RMS_EPS);
        GAS f32x4* yw = (GAS f32x4*)(ydst_s + (size_t)m * D) + lane;
#pragma unroll
        for (int j = 0; j < 4; ++j) yw[64 * j] = v[j] * r * gg[j];
    }
    for (int m = gw; m < MP; m += NGW) {
        GAS f32x4* yr = (GAS f32x4*)(F.out + O_YP + (size_t)m * D) + lane;
        const float r = 1.0f / sqrtf(F.SS2[m] * (1.f / 1024.f) + RMS_EPS);
        f32x4 v[4];
#pragma unroll
        for (int j = 0; j < 4; ++j) v[j] = yr[64 * j];
        GAS f32x4* yw = (GAS f32x4*)(ydst_p + (size_t)m * D) + lane;
#pragma unroll
        for (int j = 0; j < 4; ++j) yw[64 * j] = v[j] * r * gg[j];
    }
}

namespace att {
typedef short bf16x8 __attribute__((ext_vector_type(8)));
typedef short s16x4 __attribute__((ext_vector_type(4)));
typedef float f32x16 __attribute__((ext_vector_type(16)));
typedef unsigned u32x4 __attribute__((ext_vector_type(4)));
typedef float f32x2_t __attribute__((ext_vector_type(2))); typedef __bf16 bf16x2_t __attribute__((ext_vector_type(2)));
#define ALAS __attribute__((address_space(3)))
constexpr int A_K = 0, A_V = 16384, A_WS = 32768, A_PBLK = 34816, A_SELM = 43264, A_OST = 43520, A_QSLOT = 109056, A_BON = 109120, A_END = 109248;
constexpr int S_SC = 0, S_PH = 1024, S_PBL = 2048, S_SEL = 2304, S_ML = 2560, S_MO = 3072, S_RES = 11264, S_END = 14336;
constexpr float NEGINF = -INFINITY, MINIT = -1e30f, THR = 8.0f;

__device__ __forceinline__ int crow(int r, int hi) { return (r & 3) + 8 * (r >> 2) + 4 * hi; }
__device__ __forceinline__ unsigned cvtpk_s(float lo, float hi) { f32x2_t v = {lo, hi}; bf16x2_t b = __builtin_convertvector(v, bf16x2_t); return __builtin_bit_cast(unsigned, b); }
__device__ __forceinline__ float sum_halves(float v) { auto rr = __builtin_amdgcn_permlane32_swap(__float_as_uint(v), __float_as_uint(v), false, false); return __uint_as_float(rr[0]) + __uint_as_float(rr[1]); }

__device__ __forceinline__ void qk_tile(f32x16& p0, f32x16& p1, const ALAS char* kslot, const bf16x8 (&qr)[4], int r32, int hi) {
    const ALAS char* kb = kslot + hi * 1024 + r32 * 16;
    p0 = (f32x16){}; p1 = (f32x16){};
#pragma unroll
    for (int d0 = 0; d0 < 4; ++d0) {
        const bf16x8 b0 = *(const ALAS bf16x8*)(kb + d0 * 2048), b1 = *(const ALAS bf16x8*)(kb + d0 * 2048 + 512);
        p0 = __builtin_amdgcn_mfma_f32_32x32x16_bf16(b0, qr[d0], p0, 0, 0, 0); p1 = __builtin_amdgcn_mfma_f32_32x32x16_bf16(b1, qr[d0], p1, 0, 0, 0); }
}
__device__ __forceinline__ void pv_tile(f32x16 (&o)[2], unsigned vb, bf16x8 pa0, bf16x8 pa1, bf16x8 pa2, bf16x8 pa3) {
#pragma unroll
    for (int d0 = 0; d0 < 2; ++d0) { s16x4 lo[4], hi[4];
#pragma unroll
        for (int ks = 0; ks < 4; ++ks) {
            asm volatile("ds_read_b64_tr_b16 %0,%1 offset:%c2" : "=&v"(lo[ks]) : "v"(vb), "i"(d0 * 4096 + ks * 1024) : "memory");
            asm volatile("ds_read_b64_tr_b16 %0,%1 offset:%c2" : "=&v"(hi[ks]) : "v"(vb), "i"(d0 * 4096 + ks * 1024 + 512) : "memory"); }
        asm volatile("s_waitcnt lgkmcnt(0)" ::: "memory"); __builtin_amdgcn_sched_barrier(0);
#define ATT_PK(k) (bf16x8){lo[k][0], lo[k][1], lo[k][2], lo[k][3], hi[k][0], hi[k][1], hi[k][2], hi[k][3]}
        o[d0] = __builtin_amdgcn_mfma_f32_32x32x16_bf16(pa0, ATT_PK(0), o[d0], 0, 0, 0);
        o[d0] = __builtin_amdgcn_mfma_f32_32x32x16_bf16(pa1, ATT_PK(1), o[d0], 0, 0, 0);
        o[d0] = __builtin_amdgcn_mfma_f32_32x32x16_bf16(pa2, ATT_PK(2), o[d0], 0, 0, 0);
        o[d0] = __builtin_amdgcn_mfma_f32_32x32x16_bf16(pa3, ATT_PK(3), o[d0], 0, 0, 0);
#undef ATT_PK
    }
}
__device__ __forceinline__ float rowmax32(const f32x16& p0, const f32x16& p1) {
    float a = fmaxf(p0[0], p1[0]);
#pragma unroll
    for (int r = 1; r < 16; ++r) a = fmaxf(a, fmaxf(p0[r], p1[r]));
    auto rr = __builtin_amdgcn_permlane32_swap(__float_as_uint(a), __float_as_uint(a), false, false);
    return fmaxf(__uint_as_float(rr[0]), __uint_as_float(rr[1]));
}
struct SoftState { float m, l; };
__device__ __forceinline__ void softmax_step(f32x16& p0, f32x16& p1, SoftState& st, f32x16 (&o)[2], ALAS float* wsf, int r32, int hi) {
    const float rm = rowmax32(p0, p1);
    if (__any(rm > st.m + THR)) {
        const float mn = fmaxf(st.m, rm); const float alpha = __builtin_amdgcn_exp2f(st.m - mn); st.m = mn; st.l *= alpha;
        if (hi == 0) wsf[r32] = alpha;
        asm volatile("s_waitcnt lgkmcnt(0)" ::: "memory");
#pragma unroll
        for (int r = 0; r < 16; ++r) { const float f = wsf[crow(r, hi)]; o[0][r] *= f; o[1][r] *= f; }
    }
    float s = 0.f;
#pragma unroll
    for (int r = 0; r < 16; ++r) { p0[r] = __builtin_amdgcn_exp2f(p0[r] - st.m); p1[r] = __builtin_amdgcn_exp2f(p1[r] - st.m); s += p0[r] + p1[r]; }
    st.l += s;
}
__device__ __forceinline__ void pv_from_p(f32x16 (&o)[2], const f32x16& p0, const f32x16& p1, unsigned vb) {
    u32x4 w0, w1, w2, w3;
    w0 = (u32x4){cvtpk_s(p0[0], p0[1]), cvtpk_s(p0[2], p0[3]), cvtpk_s(p0[4], p0[5]), cvtpk_s(p0[6], p0[7])};
    w1 = (u32x4){cvtpk_s(p0[8], p0[9]), cvtpk_s(p0[10], p0[11]), cvtpk_s(p0[12], p0[13]), cvtpk_s(p0[14], p0[15])};
    w2 = (u32x4){cvtpk_s(p1[0], p1[1]), cvtpk_s(p1[2], p1[3]), cvtpk_s(p1[4], p1[5]), cvtpk_s(p1[6], p1[7])};
    w3 = (u32x4){cvtpk_s(p1[8], p1[9]), cvtpk_s(p1[10], p1[11]), cvtpk_s(p1[12], p1[13]), cvtpk_s(p1[14], p1[15])};
    pv_tile(o, vb, __builtin_bit_cast(bf16x8, w0), __builtin_bit_cast(bf16x8, w1), __builtin_bit_cast(bf16x8, w2), __builtin_bit_cast(bf16x8, w3));
}
template <bool FIRST> __device__ __forceinline__ void fold_branch(ALAS float* stg, const f32x16 (&o)[2], float fq, ALAS float* wsf, int r32, int hi) {
    if (hi == 0) wsf[r32] = fq;
    asm volatile("s_waitcnt lgkmcnt(0)" ::: "memory");
    ALAS float* sp = stg + hi * 256 + r32;
#pragma unroll
    for (int r = 0; r < 16; ++r) { const float f = wsf[4 * hi + (r & 3) + 8 * (r >> 2)]; const int ro = ((r & 3) + 8 * (r >> 2)) * 64;
        if (FIRST) { sp[ro] = o[0][r] * f; sp[ro + 32] = o[1][r] * f; } else { sp[ro] += o[0][r] * f; sp[ro + 32] += o[1][r] * f; } }
}

__device__ __forceinline__ void prompt_unit(Frame& F, int b, int h, int qb) {
    frame_fill(F);
    int tid = F.tid; asm volatile("" : "+v"(tid));
    const int lane = tid & 63, wid = F.wave, r32 = lane & 31, hi = lane >> 5, g = wid >> 1, qh = wid & 1;
    ALAS char* L = (ALAS char*)F.lds;
    ALAS float* wsf = (ALAS float*)(L + A_WS) + wid * 64;
    ALAS float* PBLK = (ALAS float*)(L + A_PBLK);
    ALAS unsigned* SELM = (ALAS unsigned*)(L + A_SELM);
    ALAS float* BON = (ALAS float*)(L + A_BON);
    ALAS float* stg = (ALAS float*)(L + A_OST) + wid * 2048;
    const int head = 4 * h + g, rowb = b * SEQ, q0 = qb * 64, qi = 32 * qh + r32;
    const size_t qrow = (size_t)(rowb + q0 + qi);
    const int krow = tid & 63, kch = tid >> 6;
    const int vrow = 16 * (wid & 3) + (lane >> 2), vcol = (wid >> 2) * 32 + (lane & 3) * 8;
    const bf16* KVh = F.KVb + (size_t)rowb * 768 + h * 64;
    const unsigned vb0 = (unsigned)(uintptr_t)(L + A_V) + ((lane >> 4) & 1) * 32 + (lane & 3) * 8 + (4 * hi + ((lane & 15) >> 2)) * 64;
    u32x4 kreg, vreg;
#define LOAD_TILE(t, kcol, vcolbase) do { kreg = *(const u32x4*)(KVh + (size_t)(64 * (t) + krow) * 768 + (kcol) + kch * 8); vreg = *(const u32x4*)(KVh + (size_t)(64 * (t) + vrow) * 768 + (vcolbase) + vcol); } while (0)
#define STORE_TILE(slot) do { *(ALAS u32x4*)(L + A_K + (slot) * 8192 + tid * 16) = kreg; *(ALAS u32x4*)(L + A_V + (slot) * 8192 + tid * 16) = vreg; } while (0)
    { const bf16* kc = F.KCP + (size_t)((b * 2 + h) * 64) * 64; const bf16* vc = F.VCP + (size_t)((b * 2 + h) * 64) * 64;
      kreg = *(const u32x4*)(kc + krow * 64 + kch * 8); vreg = *(const u32x4*)(vc + vrow * 64 + vcol); }
    for (int i = tid; i < 64 * 33; i += 512) PBLK[i] = 0.f;
    if (tid < 32) BON[tid] = (tid <= qb) ? ((tid == 0 || tid + 1 >= qb) ? 5.0f : 0.f) : NEGINF;
    bf16x8 qr[4];
#pragma unroll
    for (int d0 = 0; d0 < 4; ++d0) qr[d0] = *(const bf16x8*)(F.Qb + qrow * 512 + head * 64 + d0 * 16 + hi * 8);
    const float g_cmp = F.GATE[qrow * 32 + head * 3 + 0], g_sel = F.GATE[qrow * 32 + head * 3 + 1], g_win = F.GATE[qrow * 32 + head * 3 + 2];
    STORE_TILE(0);
    LOAD_TILE(0, 256, 384);
    __syncthreads();
    const int xq = qi - 4 * hi;
    f32x16 o[2], p0, p1;
#ifndef X_NOCMP
    {
        qk_tile(p0, p1, L + A_K, qr, r32, hi);
        const int ncv = (q0 + qi + 1) >> 5;
#pragma unroll
        for (int r = 0; r < 16; ++r) { const int c = (r & 3) + 8 * (r >> 2); if (c >= ncv - 4 * hi) p0[r] = NEGINF; if (c + 32 >= ncv - 4 * hi) p1[r] = NEGINF; }
        const float rm = rowmax32(p0, p1); const float m = (rm == NEGINF) ? 0.f : rm;
        float s = 0.f;
#pragma unroll
        for (int r = 0; r < 16; ++r) { p0[r] = __builtin_amdgcn_exp2f(p0[r] - m); p1[r] = __builtin_amdgcn_exp2f(p1[r] - m); s += p0[r] + p1[r]; }
        s = sum_halves(s);
        const float inv = (s > 0.f) ? 1.0f / s : 0.f;
#pragma unroll
        for (int k = 0; k < 8; ++k) { const int blk = 4 * (k >> 1) + 2 * hi + (k & 1);
            atomicAdd((float*)(PBLK + qi * 33 + blk), (p0[2 * k] + p0[2 * k + 1]) * inv); atomicAdd((float*)(PBLK + qi * 33 + blk + 16), (p1[2 * k] + p1[2 * k + 1]) * inv); }
        o[0] = (f32x16){}; o[1] = (f32x16){};
        pv_from_p(o, p0, p1, vb0);
        fold_branch<true>(stg, o, g_cmp * inv, wsf, r32, hi);
    }
#endif
    __syncthreads();
#ifndef X_NOTOPK
    {
        const int q = tid >> 3, part = tid & 7;
        int key[32];
#pragma unroll
        for (int j = 0; j < 32; ++j) key[j] = (int)((__float_as_uint(PBLK[q * 33 + j] + BON[j]) & ~31u) | (unsigned)(31 - j));
        unsigned bits = 0u;
#pragma unroll
        for (int ii = 0; ii < 4; ++ii) { const int i = part * 4 + ii; int ki = key[0];
#pragma unroll
            for (int j = 1; j < 32; ++j) ki = (j == i) ? key[j] : ki;
            unsigned rank = 0u;
#pragma unroll
            for (int j = 0; j < 32; ++j) rank += (unsigned)(ki - key[j]) >> 31;
            if (rank < 16u) bits |= 1u << i; }
        bits |= __shfl_xor(bits, 1); bits |= __shfl_xor(bits, 2); bits |= __shfl_xor(bits, 4);
        if (part == 0) SELM[q] = bits;
    }
#endif
    STORE_TILE(1);
    __syncthreads();
    const unsigned selm = SELM[qi];
    const int tw0 = (qb >= 8) ? qb - 8 : 0;
#ifndef X_NOSEL
    {
        SoftState st; st.m = MINIT; st.l = 0.f; o[0] = (f32x16){}; o[1] = (f32x16){};
        for (int t = 0; t <= qb; ++t) {
            const int slot = (t + 1) & 1;
            if (t < qb) LOAD_TILE(t + 1, 256, 384); else LOAD_TILE(tw0, 512, 640);
            const bool sel = (selm >> t) & 1u;
            if (__any(sel)) {
                qk_tile(p0, p1, L + A_K + slot * 8192, qr, r32, hi);
                if (t == qb) {
#pragma unroll
                    for (int r = 0; r < 16; ++r) { const int j = (r & 3) + 8 * (r >> 2); if (j > xq) p0[r] = NEGINF; if (j + 32 > xq) p1[r] = NEGINF; }
                }
                if (!sel) {
#pragma unroll
                    for (int r = 0; r < 16; ++r) { p0[r] = NEGINF; p1[r] = NEGINF; }
                }
                softmax_step(p0, p1, st, o, wsf, r32, hi);
                pv_from_p(o, p0, p1, vb0 + slot * 8192);
            }
            STORE_TILE(slot ^ 1);
            __syncthreads();
        }
        const float lt = sum_halves(st.l);
        fold_branch<false>(stg, o, g_sel / lt, wsf, r32, hi);
    }
#endif
#ifndef X_NOWIN
    {
        SoftState st; st.m = MINIT; st.l = 0.f; o[0] = (f32x16){}; o[1] = (f32x16){};
        int slot = qb & 1;
        for (int t = tw0; t <= qb; ++t) {
            if (t < qb) LOAD_TILE(t + 1, 512, 640);
            qk_tile(p0, p1, L + A_K + slot * 8192, qr, r32, hi);
            if (t == qb) {
#pragma unroll
                for (int r = 0; r < 16; ++r) { const int j = (r & 3) + 8 * (r >> 2); if (j > xq) p0[r] = NEGINF; if (j + 32 > xq) p1[r] = NEGINF; }
            }
            if (t + 8 == qb) {
#pragma unroll
                for (int r = 0; r < 16; ++r) { const int j = (r & 3) + 8 * (r >> 2); if (j < xq) p0[r] = NEGINF; if (j + 32 < xq) p1[r] = NEGINF; }
            }
            softmax_step(p0, p1, st, o, wsf, r32, hi);
            pv_from_p(o, p0, p1, vb0 + slot * 8192);
            if (t < qb) STORE_TILE(slot ^ 1);
            __syncthreads();
            slot ^= 1;
        }
        const float lt = sum_halves(st.l);
        fold_branch<false>(stg, o, g_win / lt, wsf, r32, hi);
    }
#endif
#undef LOAD_TILE
#undef STORE_TILE
    {
        asm volatile("s_waitcnt lgkmcnt(0)" ::: "memory");
        bf16* Ow = F.AO + (size_t)(rowb + q0 + 32 * qh) * D + 512 + head * 64;
#pragma unroll
        for (int i = 0; i < 4; ++i) { const int row = i * 8 + (lane >> 3), ch = lane & 7; const ALAS pg8::f32x4* sp = (const ALAS pg8::f32x4*)(stg + row * 64 + ch * 8);
            const pg8::f32x4 v0 = sp[0], v1 = sp[1]; u32x4 w; w.x = cvtpk_s(v0[0], v0[1]); w.y = cvtpk_s(v0[2], v0[3]); w.z = cvtpk_s(v1[0], v1[1]); w.w = cvtpk_s(v1[2], v1[3]);
            *(u32x4*)(Ow + (size_t)row * D + ch * 8) = w; }
    }
}

struct KeyState { float m[4], l[4], o[4][8]; };
__device__ __forceinline__ void ks_init(KeyState& S) {
#pragma unroll
    for (int g = 0; g < 4; ++g) { S.m[g] = MINIT; S.l[g] = 0.f;
#pragma unroll
        for (int d = 0; d < 8; ++d) S.o[g][d] = 0.f; }
}
__device__ __forceinline__ void ks_key(KeyState& S, const float (&q)[4][8], const pg8::f32x4 k0, const pg8::f32x4 k1, const pg8::f32x4 v0, const pg8::f32x4 v1, bool valid) {
    float s[4];
#pragma unroll
    for (int g = 0; g < 4; ++g) { float a = q[g][0] * k0[0] + q[g][1] * k0[1] + q[g][2] * k0[2] + q[g][3] * k0[3] + q[g][4] * k1[0] + q[g][5] * k1[1] + q[g][6] * k1[2] + q[g][7] * k1[3];
        a += __shfl_xor(a, 1); a += __shfl_xor(a, 2); a += __shfl_xor(a, 4); s[g] = valid ? a : NEGINF; }
#pragma unroll
    for (int g = 0; g < 4; ++g) {
        if (s[g] > S.m[g] + THR) { const float al = __builtin_amdgcn_exp2f(S.m[g] - s[g]); S.m[g] = s[g]; S.l[g] *= al;
#pragma unroll
            for (int d = 0; d < 8; ++d) S.o[g][d] *= al; }
        const float p = __builtin_amdgcn_exp2f(s[g] - S.m[g]); S.l[g] += p;
#pragma unroll
        for (int d = 0; d < 4; ++d) { S.o[g][d] += p * v0[d]; S.o[g][4 + d] += p * v1[d]; }
    }
}
__device__ __forceinline__ void ks_merge_publish(KeyState& S, ALAS float* ML, ALAS float* MO, int wid, int lane) {
#pragma unroll
    for (int sh = 8; sh < 64; sh <<= 1) {
#pragma unroll
        for (int g = 0; g < 4; ++g) { const float mo = __shfl_xor(S.m[g], sh), lo = __shfl_xor(S.l[g], sh); const float mn = fmaxf(S.m[g], mo);
            const float a = __builtin_amdgcn_exp2f(S.m[g] - mn), bb = __builtin_amdgcn_exp2f(mo - mn); S.l[g] = S.l[g] * a + lo * bb;
#pragma unroll
            for (int d = 0; d < 8; ++d) { const float oo = __shfl_xor(S.o[g][d], sh); S.o[g][d] = S.o[g][d] * a + oo * bb; }
            S.m[g] = mn; }
    }
    if (lane < 8) {
#pragma unroll
        for (int g = 0; g < 4; ++g) { if (lane == 0) { ML[(wid * 4 + g) * 2] = S.m[g]; ML[(wid * 4 + g) * 2 + 1] = S.l[g]; }
#pragma unroll
            for (int d = 0; d < 8; ++d) MO[(wid * 4 + g) * 64 + lane * 8 + d] = S.o[g][d]; }
    }
}
__device__ __forceinline__ void ks_combine(ALAS float* ML, ALAS float* MO, ALAS float* RESb, int tid) {
    if (tid < 256) { const int g = tid >> 6, d = tid & 63; float M = MINIT;
#pragma unroll
        for (int w = 0; w < 8; ++w) M = fmaxf(M, ML[(w * 4 + g) * 2]);
        float Ls = 0.f, Os = 0.f;
#pragma unroll
        for (int w = 0; w < 8; ++w) { const float f = __builtin_amdgcn_exp2f(ML[(w * 4 + g) * 2] - M); Ls += ML[(w * 4 + g) * 2 + 1] * f; Os += MO[(w * 4 + g) * 64 + d] * f; }
        RESb[g * 64 + d] = Os / Ls; }
}

__device__ __forceinline__ void sample_unit(Frame& F, int bs, int h) {
    frame_fill(F);
    int tid = F.tid; asm volatile("" : "+v"(tid));
    const int lane = tid & 63, wid = F.wave, kl = lane >> 3, dp = lane & 7;
    ALAS char* L = (ALAS char*)F.lds;
    ALAS float* SC = (ALAS float*)(L + S_SC); ALAS float* PH = (ALAS float*)(L + S_PH); ALAS float* PBL = (ALAS float*)(L + S_PBL);
    ALAS int* SEL = (ALAS int*)(L + S_SEL); ALAS float* ML = (ALAS float*)(L + S_ML); ALAS float* MO = (ALAS float*)(L + S_MO); ALAS float* RES = (ALAS float*)(L + S_RES);
    const size_t row = (size_t)(MP + bs);
    float q[4][8];
#pragma unroll
    for (int g = 0; g < 4; ++g) { const u32x4 v = *(const u32x4*)(F.Qb + row * 512 + (4 * h + g) * 64 + dp * 8);
        q[g][0] = __uint_as_float(v.x << 16); q[g][1] = __uint_as_float(v.x & 0xffff0000u); q[g][2] = __uint_as_float(v.y << 16); q[g][3] = __uint_as_float(v.y & 0xffff0000u);
        q[g][4] = __uint_as_float(v.z << 16); q[g][5] = __uint_as_float(v.z & 0xffff0000u); q[g][6] = __uint_as_float(v.w << 16); q[g][7] = __uint_as_float(v.w & 0xffff0000u); }
    { const int c = 8 * wid + kl; const float* kc = F.KCVS + ((size_t)bs * 64 + c) * 256 + h * 64 + dp * 8;
      const pg8::f32x4 k0 = *(const pg8::f32x4*)kc, k1 = *(const pg8::f32x4*)(kc + 4);
#pragma unroll
      for (int g = 0; g < 4; ++g) { float a = q[g][0] * k0[0] + q[g][1] * k0[1] + q[g][2] * k0[2] + q[g][3] * k0[3] + q[g][4] * k1[0] + q[g][5] * k1[1] + q[g][6] * k1[2] + q[g][7] * k1[3];
          a += __shfl_xor(a, 1); a += __shfl_xor(a, 2); a += __shfl_xor(a, 4); if (dp == 0) SC[g * 64 + c] = a; } }
    __syncthreads();
    if (wid < 4) { const float s = SC[wid * 64 + lane]; float mx = s;
#pragma unroll
        for (int o = 1; o < 64; o <<= 1) mx = fmaxf(mx, __shfl_xor(mx, o));
        const float p = __builtin_amdgcn_exp2f(s - mx); const float sum = wave_sum(p); PH[wid * 64 + lane] = p / sum; }
    __syncthreads();
    if (wid == 0) {
        float pb = 0.f;
        if (lane < 32) pb = (PH[2 * lane] + PH[2 * lane + 1]) + (PH[64 + 2 * lane] + PH[64 + 2 * lane + 1]) + (PH[128 + 2 * lane] + PH[128 + 2 * lane + 1]) + (PH[192 + 2 * lane] + PH[192 + 2 * lane + 1]);
        const float sc = (lane <= 32) ? pb + ((lane == 0 || lane >= 31) ? 5.0f : 0.f) : NEGINF;
        const int key = (int)((__float_as_uint(sc) & ~63u) | (unsigned)(63 - lane));
        ((ALAS int*)PBL)[lane] = key;
        asm volatile("s_waitcnt lgkmcnt(0)" ::: "memory");
        unsigned rank = 0u;
        for (int j = 0; j < 33; ++j) rank += (unsigned)(key - ((ALAS int*)PBL)[j]) >> 31;
        const bool selb = (lane < 32) && (rank < 16u);
        const unsigned long long bal = __ballot(selb);
        if (selb) SEL[__popcll(bal & ((1ull << lane) - 1ull))] = lane;
        if (lane == 0) SEL[16] = __popcll(bal);
    }
    __syncthreads();
    const int nsel = SEL[16];
    if (tid < 256) { const int g = tid >> 6, d = tid & 63; const float* vc = F.KCVS + (size_t)bs * 64 * 256 + 128 + h * 64 + d; float a = 0.f;
#pragma unroll 8
        for (int c = 0; c < 64; ++c) a += PH[g * 64 + c] * vc[(size_t)c * 256];
        RES[g * 64 + d] = a; }
    KeyState S; ks_init(S);
    for (int e = wid; e < nsel; e += 8) {
        const int B = SEL[e]; const int page = F.page_table[bs * 16 + (B >> 1)];
        const float* base = F.cache_kv + ((size_t)page * 128 + (B & 1) * 64 + kl) * 512 + 256 + h * 64 + dp * 8;
#pragma unroll
        for (int half = 0; half < 2; ++half) {
            pg8::f32x4 kk[4][2], vv[4][2];
#pragma unroll
            for (int it = 0; it < 4; ++it) { const float* p = base + (size_t)((half * 4 + it) * 8) * 512;
                kk[it][0] = __builtin_nontemporal_load((const pg8::f32x4*)p); kk[it][1] = __builtin_nontemporal_load((const pg8::f32x4*)(p + 4));
                vv[it][0] = __builtin_nontemporal_load((const pg8::f32x4*)(p + 128)); vv[it][1] = __builtin_nontemporal_load((const pg8::f32x4*)(p + 132)); }
#pragma unroll
            for (int it = 0; it < 4; ++it) ks_key(S, q, kk[it][0], kk[it][1], vv[it][0], vv[it][1], true);
        }
    }
    if (wid == 0) {
        const float* p = F.out + O_KVS + (size_t)bs * 512 + 256 + h * 64 + dp * 8;
        ks_key(S, q, *(const pg8::f32x4*)p, *(const pg8::f32x4*)(p + 4), *(const pg8::f32x4*)(p + 128), *(const pg8::f32x4*)(p + 132), kl == 0);
    }
    ks_merge_publish(S, ML, MO, wid, lane);
    __syncthreads();
    ks_combine(ML, MO, RES + 256, tid);
    __syncthreads();
    ks_init(S);
    {
        const float* base = F.cache_win + ((size_t)bs * 512 + 64 * wid + kl) * 256 + h * 64 + dp * 8;
        float* ob = F.out + O_WINS + ((size_t)bs * 512 + 64 * wid + kl) * 256 + h * 64 + dp * 8;
#pragma unroll
        for (int half = 0; half < 2; ++half) {
            pg8::f32x4 kk[4][2], vv[4][2];
#pragma unroll
            for (int it = 0; it < 4; ++it) { const float* p = base + (size_t)((half * 4 + it) * 8) * 256;
                kk[it][0] = __builtin_nontemporal_load((const pg8::f32x4*)p); kk[it][1] = __builtin_nontemporal_load((const pg8::f32x4*)(p + 4));
                vv[it][0] = __builtin_nontemporal_load((const pg8::f32x4*)(p + 128)); vv[it][1] = __builtin_nontemporal_load((const pg8::f32x4*)(p + 132)); }
#pragma unroll
            for (int it = 0; it < 4; ++it) {
                const int j = 64 * wid + (half * 4 + it) * 8 + kl;
                if (j >= 1) { float* o = ob + (ptrdiff_t)((half * 4 + it) * 8 - 1) * 256; *(pg8::f32x4*)o = kk[it][0]; *(pg8::f32x4*)(o + 4) = kk[it][1]; *(pg8::f32x4*)(o + 128) = vv[it][0]; *(pg8::f32x4*)(o + 132) = vv[it][1]; }
                ks_key(S, q, kk[it][0], kk[it][1], vv[it][0], vv[it][1], true);
            }
        }
    }
    if (wid == 0) {
        const float* p = F.out + O_WINS + ((size_t)bs * 512 + 511) * 256 + h * 64 + dp * 8;
        ks_key(S, q, *(const pg8::f32x4*)p, *(const pg8::f32x4*)(p + 4), *(const pg8::f32x4*)(p + 128), *(const pg8::f32x4*)(p + 132), kl == 0);
    }
    ks_merge_publish(S, ML, MO, wid, lane);
    __syncthreads();
    ks_combine(ML, MO, RES + 512, tid);
    __syncthreads();
    if (tid < 256) { const int g = tid >> 6, d = tid & 63; const float* gt = F.GATE + row * 32 + (4 * h + g) * 3;
        const float v = gt[0] * RES[g * 64 + d] + gt[1] * RES[256 + g * 64 + d] + gt[2] * RES[512 + g * 64 + d];
        F.AO[row * D + 512 + (4 * h + g) * 64 + d] = (bf16)f2bf(v); }
    __syncthreads();
}

__device__ __forceinline__ void attn_phase(Frame& F, int qword) {
    ALAS unsigned* QS = (ALAS unsigned*)((ALAS char*)F.lds + A_QSLOT);
    for (;;) {
        frame_fill(F);
        if (F.tid == 0) QS[0] = __hip_atomic_fetch_add((unsigned*)(F.ctl + qword), 1u, __ATOMIC_RELAXED, __HIP_MEMORY_SCOPE_AGENT);
        __syncthreads();
        const unsigned p = QS[0];
        __syncthreads();
        if (p >= 768u) break;
        const unsigned k = p / 3u, r = p % 3u;
#ifndef NO_SAMPLE
        if (r == 2u) sample_unit(F, (int)(k >> 1), (int)(k & 1u));
#else
        if (r == 2u) {}
#endif
#ifndef NO_PROMPT
        else { const unsigned u = 2u * k + r; prompt_unit(F, (int)((u & 15u) >> 1), (int)(u & 1u), 31 - (int)(u >> 4)); }
#endif
    }
}
#undef ALAS
}

struct Args { const void* in[19]; float* out; unsigned char* ws; int ph_lo, ph_hi, li, pad; };
__global__ void __launch_bounds__(NWAVES * 64, 2) mk_fwd(Args args) {
    extern __shared__ __attribute__((aligned(16))) unsigned char lds[];
    Frame F;
    F.lds = (LAS unsigned char*)lds;
    F.MISC = (volatile LAS unsigned*)(F.lds + MISC_OFF);
    F.tid = threadIdx.x; F.lane = F.tid & 63; F.wave = __builtin_amdgcn_readfirstlane(F.tid >> 6);
    F.G = gridDim.x; { const int bx = blockIdx.x; F.vcu = (F.G % 8 == 0) ? (bx % 8) * (F.G / 8) + bx / 8 : bx; }
    F.ka = (kptr_t)__builtin_amdgcn_kernarg_segment_ptr();
    frame_fill(F);
    for (int u = F.tid; u < (LDS_BYTES - LDSCTL_OFF) / 4; u += NWAVES * 64) ((LAS unsigned*)(F.lds + LDSCTL_OFF))[u] = 0u;
    __syncthreads();
    XcdBarrier bar; bar.bar = (unsigned*)(F.ctl + CW_BAR); bar.x = 0; bar.st = nullptr;
    if (N_LAUNCHES == 1) bar = xcd_barrier_post((unsigned*)(F.ctl + CW_BAR), F.MISC + 8);
#define GRID_BAR() do { if (N_LAUNCHES == 1) { xcd_barrier(bar); } } while (0)
    const int lo = args.ph_lo, hi = args.ph_hi;
#ifndef PH_MASK
#define PH_MASK 255
#endif
#define IN(k) (((PH_MASK >> (k)) & 1) && lo <= (k) && (k) < hi)
#define BOTH(k) (IN(k) && IN((k) + 1))

#ifndef REP_PHASE
#define REP_PHASE -1
#endif
    if (IN(0)) { if (REP_PHASE == 0) { frame_fill(F); p0_prologue(F); GRID_BAR(); } frame_fill(F); p0_prologue(F); if (BOTH(0)) GRID_BAR(); }
    if (IN(1)) {
        frame_fill(F);
        pg8::Gemm g{F.XN, F.Win_t, MALL, NINP, D}; pg8::StaticOrder S; S.init(MALL, NINP, F.G, (int)blockIdx.x);
        pg8::EpiInProj E{F.Gb, F.Qb, F.KVb, F.GATE, F.out};
        if (REP_PHASE == 1) { pg8::gemm_phase<pg8::EpiInProj, pg8::StaticOrder, PG8_ALIGN, PG8_SP2>(F.lds + RING_OFF, g, S, E); GRID_BAR(); }
        pg8::gemm_phase<pg8::EpiInProj, pg8::StaticOrder, PG8_ALIGN, PG8_SP2>(F.lds + RING_OFF, g, S, E);
        if (BOTH(1)) GRID_BAR();
    }
    if (IN(2)) { if (REP_PHASE == 2) { frame_fill(F); p2_phase(F); GRID_BAR(); } frame_fill(F); p2_phase(F); if (BOTH(2)) GRID_BAR(); }
    if (IN(3)) { if (REP_PHASE == 3) { frame_fill(F); att::attn_phase(F, CW_QUEUE + 64); GRID_BAR(); } frame_fill(F); att::attn_phase(F, CW_QUEUE); if (BOTH(3)) GRID_BAR(); }
    if (IN(4)) {
        frame_fill(F);
        pg8::Gemm g{F.AO, F.Wout_t, MP, D, D}; pg8::StaticOrder S; S.init(MP, D, F.G, (int)blockIdx.x);
        if (REP_PHASE == 4) { pg8::EpiOutProj E0{F.x_prompt, F.out + O_YP, F.HB, F.g_mlp, F.SS1 + 65536}; pg8::gemm_phase<pg8::EpiOutProj, pg8::StaticOrder, PG8_ALIGN, PG8_SP2>(F.lds + RING_OFF, g, S, E0); GRID_BAR(); frame_fill(F); }
        pg8::EpiOutProj E{F.x_prompt, F.out + O_YP, F.HB, F.g_mlp, F.SS1};
        pg8::gemm_phase<pg8::EpiOutProj, pg8::StaticOrder, PG8_ALIGN, PG8_SP2>(F.lds + RING_OFF, g, S, E);
        frame_fill(F);
        for (int it = F.vcu; it < 64; it += F.G) s_outproj_item(F, it);
        if (BOTH(4)) GRID_BAR();
    }
    if (IN(5)) {
        frame_fill(F);
        pg8::Gemm g{F.HB, F.Wup_t, MP, FF, D}; pg8::StaticOrder S; S.init(MP, FF, F.G, (int)blockIdx.x);
        pg8::EpiUp E{F.MID, F.SS1};
        if (REP_PHASE == 5) { pg8::gemm_phase<pg8::EpiUp, pg8::StaticOrder, PG8_ALIGN, PG8_SP2>(F.lds + RING_OFF, g, S, E); GRID_BAR(); }
        pg8::gemm_phase<pg8::EpiUp, pg8::StaticOrder, PG8_ALIGN, PG8_SP2>(F.lds + RING_OFF, g, S, E);
        frame_fill(F);
        for (int it = F.vcu; it < 256; it += F.G) s_up_item(F, it);
        if (REP_PHASE == 8) { GRID_BAR(); frame_fill(F); for (int it = F.vcu; it < 256; it += F.G) s_up_item(F, it); }
        if (BOTH(5)) GRID_BAR();
    }
    if (IN(6)) {
        frame_fill(F);
        pg8::Gemm g{F.MID, F.Wdn_t, MP, D, FF}; pg8::StaticOrder S; S.init(MP, D, F.G, (int)blockIdx.x);
        if (REP_PHASE == 6) { pg8::EpiDown E0{F.out + O_YP, (float*)(args.ws + WS_END), F.SS1 + 65536}; pg8::gemm_phase<pg8::EpiDown, pg8::StaticOrder, PG8_ALIGN, PG8_SP2>(F.lds + RING_OFF, g, S, E0); GRID_BAR(); frame_fill(F); }
        pg8::EpiDown E{F.out + O_YP, F.out + O_YP, F.SS2};
        pg8::gemm_phase<pg8::EpiDown, pg8::StaticOrder, PG8_ALIGN, PG8_SP2>(F.lds + RING_OFF, g, S, E);
        frame_fill(F);
        for (int it = F.vcu; it < 256; it += F.G) s_down_item(F, it);
        if (BOTH(6)) GRID_BAR();
    }
    if (IN(7)) { if (REP_PHASE == 7) { frame_fill(F); p7_phase(F, (float*)(args.ws + WS_END), (float*)(args.ws + WS_END) + (size_t)MP * D); GRID_BAR(); } frame_fill(F); p7_phase(F, F.out + O_YP, F.out + O_YS); }
#undef IN
#undef BOTH
#undef GRID_BAR
}

extern "C" void kernel_launch(void* const* d_in, const int* in_sizes, int n_in, void* d_out, int out_size, void* d_ws, size_t ws_size, hipStream_t stream) {
    static int grid = 0;
    if (grid == 0) {
        if (n_in != 19 || in_sizes[0] != MP * D || out_size != (int)O_END || ws_size < WS_END + 68 * MiB) {
            fprintf(stderr, "kernel_launch: unexpected problem (n_in %d, in0 %d, out %d, ws %zu); nothing launched\n", n_in, n_in > 0 ? in_sizes[0] : -1, out_size, ws_size); grid = -1; return; }
        int dev = 0, cus = 0, per_cu = 0;
        if (hipGetDevice(&dev) != hipSuccess || hipDeviceGetAttribute(&cus, hipDeviceAttributeMultiprocessorCount, dev) != hipSuccess) { fprintf(stderr, "kernel_launch: device query failed\n"); grid = -1; return; }
        if (hipFuncSetAttribute((const void*)mk_fwd, hipFuncAttributeMaxDynamicSharedMemorySize, LDS_BYTES) != hipSuccess) { fprintf(stderr, "kernel_launch: hipFuncSetAttribute failed\n"); grid = -1; return; }
        if (hipOccupancyMaxActiveBlocksPerMultiprocessor(&per_cu, (const void*)mk_fwd, NWAVES * 64, LDS_BYTES) != hipSuccess || per_cu < 1) {
            fprintf(stderr, "kernel_launch: occupancy query reports %d workgroups per CU; nothing launched\n", per_cu); (void)hipGetLastError(); grid = -1; return; }
        grid = cus;
    }
    if (grid < 0) return;
    if (hipMemsetAsync((char*)d_ws + WS_CTL, 0, CTL_ZERO_BYTES, stream) != hipSuccess) { fprintf(stderr, "kernel_launch: hipMemsetAsync failed\n"); return; }
    Args a{};
    for (int i = 0; i < 19; ++i) a.in[i] = d_in[i];
    a.out = (float*)d_out; a.ws = (unsigned char*)d_ws;
    for (int li = 0; li < N_LAUNCHES; ++li) {
        if (N_LAUNCHES == 1) { a.ph_lo = 0; a.ph_hi = N_PHASES; } else { a.ph_lo = li; a.ph_hi = li + 1; }
        a.li = li;
        hipLaunchKernelGGL(mk_fwd, dim3(grid), dim3(NWAVES * 64), LDS_BYTES, stream, a);
        const hipError_t le = hipPeekAtLastError();
        if (le != hipSuccess) { fprintf(stderr, "kernel_launch: launch %d failed: %s\n", li, hipGetErrorName(le)); break; }
    }
}
```

```cpp
#include <hip/hip_runtime.h>
#include <cstdio>
#include <cstdint>
namespace pg8 {
#define PG8_LAS __attribute__((address_space(3)))
typedef unsigned short bf16_t;
typedef short bf16x8 __attribute__((ext_vector_type(8)));
typedef float f32x4 __attribute__((ext_vector_type(4)));
typedef unsigned u32x4 __attribute__((ext_vector_type(4)));
constexpr int BM = 256, BK = 64, HALF = 128, HTB = HALF * BK * 2  , STAGE_BYTES = 8 * HTB, NXCD = 8, WGM = 8;

__host__ __device__ __forceinline__ int lds_byte(int r, int c) { const int st = (r >> 4) * 2 + (c >> 5), rr = r & 15, cc = c & 31, ob = rr * 64 + cc * 2; return st * 1024 + (ob ^ (((ob >> 9) & 1) << 5)); }
__host__ __device__ __forceinline__ void stage_rc(int b, int& R, int& C) { const int st = b / 1024, sb = b % 1024, swz = sb ^ (((sb >> 9) & 1) << 5); R = (st >> 1) * 16 + swz / 64; C = (st & 1) * 32 + (swz % 64) / 2; }
__host__ __device__ __forceinline__ int perm32(int rho) { const int n = rho >> 4, i = rho & 15; return 8 * (i >> 2) + 4 * n + (i & 3); }

struct Unit { int pm, pn; };
struct Gemm { const bf16_t* A; const bf16_t* Bt; int M, N, K; };

struct StaticOrder {
    int nM, nN, nwg, G, c;
    __host__ __device__ void init(int M, int N, int G_, int c_) { nM = M / BM; nN = N / BM; nwg = nM * nN; G = G_; c = c_; }
    __host__ __device__ bool next(int i, Unit& u) const {
        const long L = (long)i * G + c; if (L >= nwg) return false;
        int wgid = (int)L; { const int q = nwg / NXCD, r = nwg % NXCD, xcd = wgid % NXCD, off = wgid / NXCD; wgid = (xcd < r ? xcd * (q + 1) : r * (q + 1) + (xcd - r) * q) + off; }
        const int nig = WGM * nN, gid = wgid / nig, fm = gid * WGM, gsz = (nM - fm) < WGM ? (nM - fm) : WGM;
        u.pm = fm + ((wgid % nig) % gsz); u.pn = (wgid % nig) / gsz; return true;
    }
    __device__ __forceinline__ void a_ready(const Unit&) const {}
    __device__ __forceinline__ void done(const Unit&) const {}
};


constexpr int MP = 16384, MS = 128, MALL = 16640;
constexpr int NVALID = MP + MS;
constexpr size_t O_YP = 0, O_YS = 16777216, O_KVP = 16908288, O_WINP = 25296896, O_CONVP = 26345472, O_KVS = 26468352, O_WINS = 26533888, O_CONVS = 43311104, O_END = 45277184;
constexpr float QSCALE = 0.125f * 1.4426950408889634f;

__device__ __forceinline__ unsigned cvt_pk_bf16(float lo, float hi) { unsigned r; asm volatile("v_cvt_pk_bf16_f32 %0, %1, %2" : "=v"(r) : "v"(lo), "v"(hi)); return r; }
__device__ __forceinline__ float fast_sigmoid(float x) { return __builtin_amdgcn_rcpf(1.0f + __builtin_amdgcn_exp2f(-1.4426950408889634f * x)); }
__device__ __forceinline__ u32x4 pack8(const f32x4 a, const f32x4 b) { u32x4 w; w.x = cvt_pk_bf16(a[0], a[1]); w.y = cvt_pk_bf16(a[2], a[3]); w.z = cvt_pk_bf16(b[0], b[1]); w.w = cvt_pk_bf16(b[2], b[3]); return w; }

struct EpiInProj {
    static constexpr bool PERM = true, AFTER_DRAIN = false;
    bf16_t* G; bf16_t* Q; bf16_t* KV; float* GATE; float* out;
    __device__ __forceinline__ void operator()(const f32x4 (&acc)[2][2][4][2], const Unit& u, int wr, int wc, int fr, int fq) const {
        const int pn = u.pn; const int rb = u.pm * BM + wr * 64 + fr; const int cl = wc * 32 + 8 * fq;
        if (pn < 4) {
#pragma unroll
            for (int ai = 0; ai < 2; ++ai)
#pragma unroll
                for (int m = 0; m < 4; ++m) { const int row = rb + ai * HALF + m * 16; if (row >= NVALID) continue;
                    f32x4 g0, g1;
#pragma unroll
                    for (int e = 0; e < 4; ++e) { g0[e] = acc[ai][0][m][0][e] * fast_sigmoid(acc[ai][1][m][0][e]); g1[e] = acc[ai][0][m][1][e] * fast_sigmoid(acc[ai][1][m][1][e]); }
                    const int c = 128 * pn + cl;
                    *(u32x4*)(G + (size_t)row * 512 + c) = pack8(g0, g1);
                    float* dst = nullptr;
                    if (row < MP) { const int t = row & 2047; if (t >= 2018) dst = out + O_CONVP + ((size_t)((row >> 11) * 30 + t - 2018) * 512 + c); }
                    else dst = out + O_CONVS + ((size_t)((row - MP) * 30 + 29) * 512 + c);
                    if (dst) { *(f32x4*)dst = g0; *(f32x4*)(dst + 4) = g1; } }
        } else if (pn < 6) {
#pragma unroll
            for (int ai = 0; ai < 2; ++ai)
#pragma unroll
                for (int m = 0; m < 4; ++m) { const int row = rb + ai * HALF + m * 16;
#pragma unroll
                    for (int bj = 0; bj < 2; ++bj) { const int c = 256 * (pn - 4) + 128 * bj + cl;
                        *(u32x4*)(Q + (size_t)row * 512 + c) = pack8(acc[ai][bj][m][0] * QSCALE, acc[ai][bj][m][1] * QSCALE); } }
        } else if (pn < 8) {
#pragma unroll
            for (int ai = 0; ai < 2; ++ai)
#pragma unroll
                for (int m = 0; m < 4; ++m) { const int row = rb + ai * HALF + m * 16; if (row >= NVALID) continue;
#pragma unroll
                    for (int bj = 0; bj < 2; ++bj) { const int c = 256 * (pn - 6) + 128 * bj + cl;
                        *(u32x4*)(KV + (size_t)row * 768 + c) = pack8(acc[ai][bj][m][0], acc[ai][bj][m][1]);
                        float* dst = (row < MP) ? out + O_KVP + (size_t)row * 512 + c : out + O_KVS + (size_t)(row - MP) * 512 + c;
                        *(f32x4*)dst = acc[ai][bj][m][0]; *(f32x4*)(dst + 4) = acc[ai][bj][m][1]; } }
        } else if (pn == 8) {
#pragma unroll
            for (int ai = 0; ai < 2; ++ai)
#pragma unroll
                for (int m = 0; m < 4; ++m) { const int row = rb + ai * HALF + m * 16; if (row >= NVALID) continue;
#pragma unroll
                    for (int bj = 0; bj < 2; ++bj) { const int c = 128 * bj + cl;
                        *(u32x4*)(KV + (size_t)row * 768 + 512 + c) = pack8(acc[ai][bj][m][0], acc[ai][bj][m][1]);
                        float* dst = nullptr;
                        if (row < MP) { const int t = row & 2047; if (t >= 1536) dst = out + O_WINP + ((size_t)((row >> 11) * 512 + t - 1536) * 256 + c); }
                        else dst = out + O_WINS + ((size_t)((row - MP) * 512 + 511) * 256 + c);
                        if (dst) { *(f32x4*)dst = acc[ai][bj][m][0]; *(f32x4*)(dst + 4) = acc[ai][bj][m][1]; } } }
        } else {
            if (wc == 0 && fq < 3) {
#pragma unroll
                for (int ai = 0; ai < 2; ++ai)
#pragma unroll
                    for (int m = 0; m < 4; ++m) { const int row = rb + ai * HALF + m * 16; if (row >= NVALID) continue;
                        f32x4 g0, g1;
#pragma unroll
                        for (int e = 0; e < 4; ++e) { g0[e] = fast_sigmoid(acc[ai][0][m][0][e]); g1[e] = fast_sigmoid(acc[ai][0][m][1][e]); }
                        float* dst = GATE + (size_t)row * 32 + 8 * fq; *(f32x4*)dst = g0; *(f32x4*)(dst + 4) = g1; }
            }
        }
    }
};

struct EpiOutProj {
    static constexpr bool PERM = false, AFTER_DRAIN = false;
    const float* x; float* h; bf16_t* hb; const float* g; float* ss;
    __device__ __forceinline__ void operator()(const f32x4 (&acc)[2][2][4][2], const Unit& u, int wr, int wc, int fr, int fq) const {
        const int col0 = u.pn * BM + wc * 32 + 4 * fq;
        f32x4 gv[2][2];
#pragma unroll
        for (int bj = 0; bj < 2; ++bj)
#pragma unroll
            for (int n = 0; n < 2; ++n) gv[bj][n] = *(const f32x4*)(g + col0 + bj * HALF + n * 16);
#pragma unroll
        for (int ai = 0; ai < 2; ++ai)
#pragma unroll
            for (int m = 0; m < 4; ++m) { const int row = u.pm * BM + ai * HALF + wr * 64 + m * 16 + fr; const size_t off = (size_t)row * 1024 + col0; float s = 0.f;
#pragma unroll
                for (int bj = 0; bj < 2; ++bj)
#pragma unroll
                    for (int n = 0; n < 2; ++n) { const f32x4 xv = *(const f32x4*)(x + off + bj * HALF + n * 16); const f32x4 hv = xv + acc[ai][bj][m][n];
                        *(f32x4*)(h + off + bj * HALF + n * 16) = hv; s += (hv[0] * hv[0] + hv[1] * hv[1]) + (hv[2] * hv[2] + hv[3] * hv[3]);
                        const f32x4 hg = hv * gv[bj][n]; unsigned w0 = cvt_pk_bf16(hg[0], hg[1]), w1 = cvt_pk_bf16(hg[2], hg[3]);
                        *(unsigned long long*)(hb + off + bj * HALF + n * 16) = (unsigned long long)w0 | ((unsigned long long)w1 << 32); }
                s += __shfl_xor(s, 16); s += __shfl_xor(s, 32);
                if (fq == 0) atomicAdd(ss + row, s); }
    }
};
struct EpiUp {
    static constexpr bool PERM = true, AFTER_DRAIN = false;
    bf16_t* mid; const float* ss;
    __device__ __forceinline__ void operator()(const f32x4 (&acc)[2][2][4][2], const Unit& u, int wr, int wc, int fr, int fq) const {
        const int col0 = u.pn * BM + wc * 32 + 8 * fq;
#pragma unroll
        for (int ai = 0; ai < 2; ++ai)
#pragma unroll
            for (int m = 0; m < 4; ++m) { const int row = u.pm * BM + ai * HALF + wr * 64 + m * 16 + fr; const float r = __builtin_amdgcn_rsqf(ss[row] * (1.0f / 1024.0f) + 1e-6f);
#pragma unroll
                for (int bj = 0; bj < 2; ++bj) { f32x4 a = acc[ai][bj][m][0] * r, b = acc[ai][bj][m][1] * r;
#pragma unroll
                    for (int e = 0; e < 4; ++e) { const float p = fmaxf(a[e], 0.f), q = fmaxf(b[e], 0.f); a[e] = p * p; b[e] = q * q; }
                    *(u32x4*)(mid + (size_t)row * 4096 + col0 + bj * HALF) = pack8(a, b); } }
    }
};
struct EpiDown {
    static constexpr bool PERM = false, AFTER_DRAIN = false;
    const float* h; float* hd; float* ss;
    __device__ __forceinline__ void operator()(const f32x4 (&acc)[2][2][4][2], const Unit& u, int wr, int wc, int fr, int fq) const {
        const int col0 = u.pn * BM + wc * 32 + 4 * fq;
#pragma unroll
        for (int ai = 0; ai < 2; ++ai)
#pragma unroll
            for (int m = 0; m < 4; ++m) { const int row = u.pm * BM + ai * HALF + wr * 64 + m * 16 + fr; const size_t off = (size_t)row * 1024 + col0; float s = 0.f;
#pragma unroll
                for (int bj = 0; bj < 2; ++bj)
#pragma unroll
                    for (int n = 0; n < 2; ++n) { const f32x4 hv = *(const f32x4*)(h + off + bj * HALF + n * 16) + acc[ai][bj][m][n];
                        *(f32x4*)(hd + off + bj * HALF + n * 16) = hv; s += (hv[0] * hv[0] + hv[1] * hv[1]) + (hv[2] * hv[2] + hv[3] * hv[3]); }
                s += __shfl_xor(s, 16); s += __shfl_xor(s, 32);
                if (fq == 0) atomicAdd(ss + row, s); }
    }
};
template <class Epi, class Sched, bool ALIGN_EPI = false, bool SP2 = false>
__device__ __forceinline__ void gemm_phase(PG8_LAS unsigned char* lds, const Gemm g, const Sched& S, const Epi& E) {
    const int tid = threadIdx.x, wid = __builtin_amdgcn_readfirstlane(tid >> 6), lane = tid & 63, wr = wid >> 2, wc = wid & 3, fr = lane & 15, fq = lane >> 4;
    const int K = g.K, nt = K / BK;
    unsigned voffA[2], voffB[2];
#pragma unroll
    for (int i = 0; i < 2; ++i) { int R, C; stage_rc(tid * 16 + i * 8192, R, C); const int Rb = Epi::PERM ? ((R & ~31) + perm32(R & 31)) : R;
        voffA[i] = (unsigned)(R * K + C) * 2u; voffB[i] = (unsigned)(Rb * K + C) * 2u; }
    const size_t kstep = (size_t)(BK * 2);
    const size_t hstep = (size_t)HALF * K * 2;
    const size_t tstep = 2 * hstep;
    const unsigned ldsw = (unsigned)wid * 1024u;
    const int aoff = lds_byte(wr * 64 + fr, fq * 8), boff = lds_byte(wc * 32 + fr, fq * 8);
#define PG8_SA(b, h) (((b) * 2 + (h)) * HTB)
#define PG8_SB(b, h) ((4 + (b) * 2 + (h)) * HTB)
#define PG8_STAGE(bufoff, gbase, voff) do { _Pragma("unroll") for (int _i = 0; _i < 2; ++_i) \
        __builtin_amdgcn_global_load_lds((const unsigned*)((const char*)(gbase) + (voff)[_i]), (PG8_LAS unsigned*)(lds + (bufoff) + ldsw + _i * 8192), 16, 0, 0); } while (0)
#define PG8_LDA(dst, b, h) do { _Pragma("unroll") for (int m = 0; m < 4; ++m) _Pragma("unroll") for (int k = 0; k < 2; ++k) dst[m][k] = *(const PG8_LAS bf16x8*)(lds + PG8_SA(b, h) + aoff + m * 2048 + k * 1024); } while (0)
#define PG8_LDB(dst, b, h) do { _Pragma("unroll") for (int n = 0; n < 2; ++n) _Pragma("unroll") for (int k = 0; k < 2; ++k) dst[n][k] = *(const PG8_LAS bf16x8*)(lds + PG8_SB(b, h) + boff + n * 2048 + k * 1024); } while (0)
#define PG8_MMA(ai, bj, At, Bt) do { __builtin_amdgcn_s_setprio(1); _Pragma("unroll") for (int m = 0; m < 4; ++m) _Pragma("unroll") for (int n = 0; n < 2; ++n) _Pragma("unroll") for (int k = 0; k < 2; ++k) \
        acc[ai][bj][m][n] = __builtin_amdgcn_mfma_f32_16x16x32_bf16(Bt[n][k], At[m][k], acc[ai][bj][m][n], 0, 0, 0); __builtin_amdgcn_s_setprio(0); } while (0)
#define PG8_WAIT_V(n) asm volatile("s_waitcnt vmcnt(" #n ")" ::: "memory")
#define PG8_WAIT_L(n) asm volatile("s_waitcnt lgkmcnt(" #n ")" ::: "memory")
#define PG8_BAR __builtin_amdgcn_s_barrier()
#define PG8_SCHED __builtin_amdgcn_sched_barrier(0)
    Unit cur, nxt; int ui = 0;
    if (!S.next(0, cur)) return;
    f32x4 acc[2][2][4][2];
#pragma unroll
    for (int a = 0; a < 2; ++a)
#pragma unroll
        for (int b = 0; b < 2; ++b)
#pragma unroll
            for (int m = 0; m < 4; ++m)
#pragma unroll
                for (int n = 0; n < 2; ++n) acc[a][b][m][n] = (f32x4){0.f, 0.f, 0.f, 0.f};
    bf16x8 At[4][2], B0[2][2], B1[2][2];
    const char* cA = (const char*)g.A + (size_t)cur.pm * tstep; const char* cB = (const char*)g.Bt + (size_t)cur.pn * tstep;
    S.a_ready(cur);
    if constexpr (SP2) {
        PG8_STAGE(PG8_SB(0, 0), cB, voffB); PG8_STAGE(PG8_SB(0, 1), cB + hstep, voffB); PG8_STAGE(PG8_SA(0, 0), cA, voffA); PG8_STAGE(PG8_SA(0, 1), cA + hstep, voffA);
        if (wr == 1) PG8_BAR;
        PG8_WAIT_V(2); PG8_BAR;
        PG8_STAGE(PG8_SB(1, 0), cB + kstep, voffB); PG8_STAGE(PG8_SA(1, 0), cA + kstep, voffA); PG8_STAGE(PG8_SB(1, 1), cB + hstep + kstep, voffB);
        PG8_WAIT_V(6); PG8_BAR;
    } else {
        PG8_STAGE(PG8_SB(0, 0), cB, voffB); PG8_STAGE(PG8_SA(0, 0), cA, voffA); PG8_STAGE(PG8_SB(0, 1), cB + hstep, voffB); PG8_STAGE(PG8_SA(0, 1), cA + hstep, voffA);
        if (wr == 1) PG8_BAR;
        PG8_WAIT_V(4); PG8_BAR;
        PG8_STAGE(PG8_SB(1, 0), cB + kstep, voffB); PG8_STAGE(PG8_SA(1, 0), cA + kstep, voffA); PG8_STAGE(PG8_SB(1, 1), cB + hstep + kstep, voffB);
        PG8_WAIT_V(6); PG8_BAR;
    }
    for (;;) {
        const bool has_next = S.next(ui + 1, nxt);
        const char* nA = has_next ? (const char*)g.A + (size_t)nxt.pm * tstep : cA; const char* nB = has_next ? (const char*)g.Bt + (size_t)nxt.pn * tstep : cB;
        for (int t = 0; t < nt; t += 2) {
            const bool last = (t == nt - 2);
            const char* a1 = cA + (size_t)(t + 1) * kstep;
            const char* a2 = last ? nA : cA + (size_t)(t + 2) * kstep; const char* b2 = last ? nB : cB + (size_t)(t + 2) * kstep;
            const char* a3 = a2 + kstep; const char* b3 = b2 + kstep;
            if (last && has_next) S.a_ready(nxt);
            if constexpr (SP2) {
            PG8_LDB(B0, 0, 0); PG8_LDB(B1, 0, 1); PG8_SCHED; PG8_LDA(At, 0, 0); PG8_STAGE(PG8_SA(1, 1), a1 + hstep, voffA);
            PG8_WAIT_V(8); PG8_WAIT_L(0); PG8_BAR; PG8_MMA(0, 0, At, B0); PG8_MMA(0, 1, At, B1); PG8_BAR; PG8_SCHED;
            PG8_LDA(At, 0, 1); PG8_STAGE(PG8_SB(0, 0), b2, voffB); PG8_STAGE(PG8_SB(0, 1), b2 + hstep, voffB); PG8_STAGE(PG8_SA(0, 0), a2, voffA);
            PG8_WAIT_V(8); PG8_WAIT_L(0); PG8_BAR; PG8_MMA(1, 0, At, B0); PG8_MMA(1, 1, At, B1); PG8_BAR; PG8_SCHED;
            PG8_LDB(B0, 1, 0); PG8_LDB(B1, 1, 1); PG8_SCHED; PG8_LDA(At, 1, 0); PG8_STAGE(PG8_SA(0, 1), a2 + hstep, voffA);
            PG8_WAIT_V(8); PG8_WAIT_L(0); PG8_BAR; PG8_MMA(0, 0, At, B0); PG8_MMA(0, 1, At, B1); PG8_BAR; PG8_SCHED;
            PG8_LDA(At, 1, 1); PG8_STAGE(PG8_SB(1, 0), b3, voffB); PG8_STAGE(PG8_SB(1, 1), b3 + hstep, voffB); PG8_STAGE(PG8_SA(1, 0), a3, voffA);
            PG8_WAIT_V(8); PG8_WAIT_L(0); PG8_BAR; PG8_MMA(1, 0, At, B0); PG8_MMA(1, 1, At, B1); PG8_BAR; PG8_SCHED;
            } else {
            PG8_LDB(B0, 0, 0); PG8_SCHED; PG8_LDA(At, 0, 0); PG8_STAGE(PG8_SA(1, 1), a1 + hstep, voffA);
            PG8_WAIT_L(8); PG8_BAR; PG8_WAIT_L(0); PG8_MMA(0, 0, At, B0); PG8_BAR; PG8_SCHED;
            PG8_LDB(B1, 0, 1); PG8_STAGE(PG8_SB(0, 0), b2, voffB);
            PG8_BAR; PG8_WAIT_L(0); PG8_MMA(0, 1, At, B1); PG8_BAR;
            PG8_LDA(At, 0, 1); PG8_STAGE(PG8_SA(0, 0), a2, voffA);
            PG8_BAR; PG8_WAIT_L(0); PG8_MMA(1, 0, At, B0); PG8_BAR; PG8_SCHED;
            PG8_STAGE(PG8_SB(0, 1), b2 + hstep, voffB);
            PG8_WAIT_V(6); PG8_BAR; PG8_MMA(1, 1, At, B1); PG8_BAR;
            PG8_LDB(B0, 1, 0); PG8_SCHED; PG8_LDA(At, 1, 0); PG8_STAGE(PG8_SA(0, 1), a2 + hstep, voffA);
            PG8_WAIT_L(8); PG8_BAR; PG8_WAIT_L(0); PG8_MMA(0, 0, At, B0); PG8_BAR; PG8_SCHED;
            PG8_LDB(B1, 1, 1); PG8_STAGE(PG8_SB(1, 0), b3, voffB);
            PG8_BAR; PG8_WAIT_L(0); PG8_MMA(0, 1, At, B1); PG8_BAR;
            PG8_LDA(At, 1, 1); PG8_STAGE(PG8_SA(1, 0), a3, voffA);
            PG8_BAR; PG8_WAIT_L(0); PG8_MMA(1, 0, At, B0); PG8_BAR; PG8_SCHED;
            PG8_STAGE(PG8_SB(1, 1), b3 + hstep, voffB);
            PG8_WAIT_V(6); PG8_BAR; PG8_MMA(1, 1, At, B1); PG8_BAR;
            }
        }
        if constexpr (ALIGN_EPI) { if (wr == 0) PG8_BAR; }
        if constexpr (!Epi::AFTER_DRAIN) { E(acc, cur, wr, wc, fr, fq); S.done(cur); }
        if (!has_next) break;
#pragma unroll
        for (int a = 0; a < 2; ++a)
#pragma unroll
            for (int b = 0; b < 2; ++b)
#pragma unroll
                for (int m = 0; m < 4; ++m)
#pragma unroll
                    for (int n = 0; n < 2; ++n) acc[a][b][m][n] = (f32x4){0.f, 0.f, 0.f, 0.f};
        cur = nxt; cA = nA; cB = nB; ++ui;
        if constexpr (ALIGN_EPI) { if (wr == 1) PG8_BAR; }
    }
    PG8_WAIT_V(0);
    if constexpr (!ALIGN_EPI) { if (wr == 0) PG8_BAR; }
    PG8_BAR;
    if constexpr (Epi::AFTER_DRAIN) { E.fused(acc, cur, wr, wc, fr, fq, lds, wid, lane); S.done(cur); }
#undef PG8_SA
#undef PG8_SB
#undef PG8_STAGE
#undef PG8_LDA
#undef PG8_LDB
#undef PG8_MMA
#undef PG8_WAIT_V
#undef PG8_WAIT_L
#undef PG8_BAR
#undef PG8_SCHED
}
}
#ifndef PG8_SP2
#define PG8_SP2 true
#endif
#ifndef PG8_ALIGN
#define PG8_ALIGN true
#endif

constexpr int NWAVES = 8;
#ifndef MK_N_LAUNCHES
#define MK_N_LAUNCHES 1
#endif
constexpr int N_LAUNCHES = MK_N_LAUNCHES;
constexpr int N_PHASES = 8;

using pg8::MP; using pg8::MS; using pg8::MALL; using pg8::NVALID;
using pg8::O_YP; using pg8::O_YS; using pg8::O_KVP; using pg8::O_WINP; using pg8::O_CONVP; using pg8::O_KVS; using pg8::O_WINS; using pg8::O_CONVS; using pg8::O_END;
constexpr int D = 1024, SEQ = 2048, NB = 8, CC = 512, FF = 4096, NIN = 2328, NINP = 2560, NPHYS = 2560;
constexpr float RMS_EPS = 1e-6f, LN_EPS = 1e-5f;

constexpr size_t MiB = 1u << 20;
constexpr size_t WS_CTL = 0, CTL_ZERO_BYTES = 2 * MiB;
constexpr size_t WS_SS1 = 256 * 1024, WS_SS2 = 384 * 1024, WS_DACC = 1 * MiB;
constexpr size_t WS_WIN = 2 * MiB, WS_WOUT = 7 * MiB, WS_WUP = 9 * MiB, WS_WDN = 17 * MiB;
constexpr size_t WS_XN = 26 * MiB, WS_G = 59 * MiB, WS_Q = 76 * MiB, WS_KV = 93 * MiB, WS_GATE = 118 * MiB;
constexpr size_t WS_KCP = 121 * MiB, WS_VCP = 121 * MiB + 256 * 1024, WS_KCVS = 122 * MiB;
constexpr size_t WS_AO = 130 * MiB, WS_HB = 163 * MiB, WS_MID = 196 * MiB, WS_END = 327 * MiB;
static_assert(WS_XN + (size_t)MALL * D * 2 <= WS_G && WS_G + (size_t)MALL * CC * 2 <= WS_Q && WS_Q + (size_t)MALL * 512 * 2 <= WS_KV && WS_KV + (size_t)MALL * 768 * 2 <= WS_GATE &&
              WS_GATE + (size_t)MALL * 32 * 4 <= WS_KCP && WS_KCVS + (size_t)MS * 64 * 256 * 4 <= WS_AO && WS_AO + (size_t)MALL * D * 2 <= WS_HB && WS_HB + (size_t)MALL * D * 2 <= WS_MID &&
              WS_MID + (size_t)MALL * FF * 2 <= WS_END, "d_ws map");
constexpr int CW_TMO = 0, CW_QUEUE = 64, CW_SPOOL = 2048;
constexpr int CW_BAR = 4096;

constexpr int RING_OFF = 0, RING_BYTES = 131072;
constexpr int LDSCTL_OFF = RING_BYTES, MISC_OFF = LDSCTL_OFF + 320;
constexpr int LDS_BYTES = 147456;

#define GAS __attribute__((address_space(1)))
#define LAS __attribute__((address_space(3)))
typedef unsigned short bf16;
typedef unsigned v4u __attribute__((ext_vector_type(4)));
typedef float f32x4 __attribute__((ext_vector_type(4)));
typedef short bf16x8 __attribute__((ext_vector_type(8)));
typedef GAS unsigned gu32;
typedef GAS unsigned long long gu64;
#define RLX_AGENT __ATOMIC_RELAXED, __HIP_MEMORY_SCOPE_AGENT
#define LDS_WAIT() asm volatile("s_waitcnt lgkmcnt(0)" ::: "memory")
#define VM_WAIT() asm volatile("s_waitcnt vmcnt(0)" ::: "memory")
__device__ __forceinline__ unsigned long long rt() { return __builtin_amdgcn_s_memrealtime(); }
__device__ __forceinline__ unsigned f2bf(float f) { unsigned u = __builtin_bit_cast(unsigned, f); return (u + 0x7fffu + ((u >> 16) & 1u)) >> 16; }
__device__ __forceinline__ unsigned pk2(float lo, float hi) { return f2bf(lo) | (f2bf(hi) << 16); }

#define XB_TMO      128
#define XB_XCNT(j)  (256  + 64 * (j))
#define XB_XSUB(j)  (1280 + 64 * (j))
#define XB_XGEN(j)  (2304 + 64 * (j))
#define XB_TOP      3328
#define XB_TOPGEN   3392
#define XCD_BAR_WORDS 3456
#define XB_SPIN_CAP (1u << 18)

__device__ __forceinline__ unsigned xb_ld(unsigned* p)              { return __hip_atomic_load(p, __ATOMIC_RELAXED, __HIP_MEMORY_SCOPE_AGENT); }
__device__ __forceinline__ unsigned xb_add(unsigned* p, unsigned v) { return __hip_atomic_fetch_add(p, v, __ATOMIC_RELAXED, __HIP_MEMORY_SCOPE_AGENT); }
__device__ __forceinline__ unsigned xb_xcc_id() { return (unsigned)__builtin_amdgcn_s_getreg((3 << 11) | 20) & 0xFu; }
#define XB_SPIN(cond, bar) do { unsigned _sp = 0; while (cond) { __builtin_amdgcn_s_sleep(1); \
    if ((++_sp & 255u) == 0u) { if (xb_ld(&(bar)[XB_TMO])) break; if (_sp > XB_SPIN_CAP) { atomicAdd(&(bar)[XB_TMO], 1u); break; } } } } while (0)

struct XcdBarrier {
    unsigned* bar; unsigned x;
    volatile LAS unsigned* st;
};

__device__ __forceinline__ XcdBarrier xcd_barrier_post(unsigned* bar, volatile LAS unsigned* st) {
    XcdBarrier b; b.bar = bar; b.x = xb_xcc_id(); b.st = st;
    if (threadIdx.x == 0) (void)xb_add(&bar[XB_XCNT(b.x)], 1u);
    return b;
}
__device__ __forceinline__ void xcd_barrier_complete(unsigned* bar, unsigned x, unsigned& nloc, unsigned& nx) {
    const unsigned G = gridDim.x * gridDim.y * gridDim.z;
    unsigned sum, cnt, mine, sp = 0u;
    for (;;) {
        sum = 0u; cnt = 0u; mine = 0u;
#pragma unroll
        for (unsigned j = 0; j < 16; ++j) { const unsigned c = xb_ld(&bar[XB_XCNT(j)]); sum += c; cnt += (c > 0u) ? 1u : 0u; mine = (j == x) ? c : mine; }
        if (sum == G) break;
        __builtin_amdgcn_s_sleep(1);
        if ((++sp & 255u) == 0u) { if (xb_ld(&bar[XB_TMO])) break; if (sp > XB_SPIN_CAP) { atomicAdd(&bar[XB_TMO], 1u); break; } }
    }
    nloc = mine > 0u ? mine : 1u; nx = cnt > 0u ? cnt : 1u;
}

__device__ __forceinline__ void xcd_barrier(const XcdBarrier& b) {
    asm volatile("s_waitcnt vmcnt(0)" ::: "memory");
    __syncthreads();
    if (threadIdx.x == 0) {
        unsigned* bar = b.bar;
        __builtin_amdgcn_s_waitcnt(0);
        unsigned nloc = b.st[0], nx = b.st[1];
        if (nloc == 0u) { xcd_barrier_complete(bar, b.x, nloc, nx); b.st[0] = nloc; b.st[1] = nx; }
        const unsigned old = xb_add(&bar[XB_XSUB(b.x)], 1u);
        const unsigned gen = old / nloc;
        if (old + 1u == (gen + 1u) * nloc) {
            __builtin_amdgcn_fence(__ATOMIC_RELEASE, "agent");
            asm volatile("s_waitcnt vmcnt(0)" ::: "memory");
            const unsigned og = xb_add(&bar[XB_TOP], 1u);
            const unsigned tg = og / nx;
            if (og + 1u == (tg + 1u) * nx) xb_add(&bar[XB_TOPGEN], 1u);
            else XB_SPIN(xb_ld(&bar[XB_TOPGEN]) == tg, bar);
            __builtin_amdgcn_fence(__ATOMIC_ACQUIRE, "agent");
            xb_add(&bar[XB_XGEN(b.x)], 1u);
            asm volatile("s_waitcnt vmcnt(0)" ::: "memory");
        } else {
            XB_SPIN(xb_ld(&bar[XB_XGEN(b.x)]) == gen, bar);
            __builtin_amdgcn_fence(__ATOMIC_ACQUIRE, "agent");
            asm volatile("s_waitcnt vmcnt(0)" ::: "memory");
        }
    }
    __syncthreads();
}

typedef const __attribute__((address_space(4))) unsigned char* kptr_t;
struct Frame {
    LAS unsigned char* lds;
    volatile LAS unsigned* MISC;
    kptr_t ka;
    gu32* ctl;
    int tid, lane, wave;
    int vcu, G;
    const float *x_prompt, *x_sample, *cache_kv, *cache_win, *state_conv; const int* page_table;
    const float *g_attn, *w_in, *w_dw, *b_dw, *ln_g, *ln_b, *w_ck, *w_cv, *w_out, *g_mlp, *w_up, *w_down, *g_final;
    float* out;
    bf16 *Win_t, *Wout_t, *Wup_t, *Wdn_t, *XN, *Gb, *Qb, *KVb, *KCP, *VCP, *AO, *HB, *MID;
    float *GATE, *KCVS, *SS1, *SS2, *DACC;
};

__device__ __forceinline__ void frame_fill(Frame& F) {
    kptr_t ka = F.ka; asm volatile("" : "+s"(ka));
    typedef const void* const __attribute__((address_space(4)))* kpp_t;
    kpp_t in = (kpp_t)ka;
    F.x_prompt = (const float*)in[0]; F.x_sample = (const float*)in[1]; F.cache_kv = (const float*)in[2]; F.cache_win = (const float*)in[3];
    F.state_conv = (const float*)in[4]; F.page_table = (const int*)in[5]; F.g_attn = (const float*)in[6]; F.w_in = (const float*)in[7];
    F.w_dw = (const float*)in[8]; F.b_dw = (const float*)in[9]; F.ln_g = (const float*)in[10]; F.ln_b = (const float*)in[11];
    F.w_ck = (const float*)in[12]; F.w_cv = (const float*)in[13]; F.w_out = (const float*)in[14]; F.g_mlp = (const float*)in[15];
    F.w_up = (const float*)in[16]; F.w_down = (const float*)in[17]; F.g_final = (const float*)in[18];
    F.out = (float*)in[19];
    unsigned char* ws = (unsigned char*)in[20];
    F.ctl = (gu32*)(ws + WS_CTL);
    F.Win_t = (bf16*)(ws + WS_WIN); F.Wout_t = (bf16*)(ws + WS_WOUT); F.Wup_t = (bf16*)(ws + WS_WUP); F.Wdn_t = (bf16*)(ws + WS_WDN);
    F.XN = (bf16*)(ws + WS_XN); F.Gb = (bf16*)(ws + WS_G); F.Qb = (bf16*)(ws + WS_Q); F.KVb = (bf16*)(ws + WS_KV); F.GATE = (float*)(ws + WS_GATE);
    F.KCP = (bf16*)(ws + WS_KCP); F.VCP = (bf16*)(ws + WS_VCP); F.KCVS = (float*)(ws + WS_KCVS);
    F.AO = (bf16*)(ws + WS_AO); F.HB = (bf16*)(ws + WS_HB); F.MID = (bf16*)(ws + WS_MID);
    F.SS1 = (float*)(ws + WS_SS1); F.SS2 = (float*)(ws + WS_SS2); F.DACC = (float*)(ws + WS_DACC);
}
__device__ __forceinline__ float wave_sum(float v) {
#pragma unroll
    for (int o = 1; o < 64; o <<= 1) v += __shfl_xor(v, o);
    return v;
}
__device__ __forceinline__ float sigmoidf_(float x) { return __builtin_amdgcn_rcpf(1.0f + __builtin_amdgcn_exp2f(-1.4426950408889634f * x)); }
__device__ __forceinline__ float bf2f(unsigned short b) { return __uint_as_float((unsigned)b << 16); }

__device__ __forceinline__ void p0_transpose_item(const float* W, int K, int N, bf16* WT, int k0, int n0, int drow0, LAS float* scr, int lane) {
#pragma unroll 8
    for (int i = 0; i < 32; ++i) { const int kk = 2 * i + (lane >> 5); const int n = n0 + (lane & 31); scr[kk * 33 + (lane & 31)] = (n < N) ? W[(size_t)(k0 + kk) * N + n] : 0.f; }
    LDS_WAIT(); asm volatile("" ::: "memory");
    const int c = lane & 7;
#pragma unroll
    for (int j = 0; j < 4; ++j) { const int n = (lane >> 3) + 8 * j; const LAS float* s = scr + (8 * c) * 33 + n;
        v4u o; o.x = pk2(s[0 * 33], s[1 * 33]); o.y = pk2(s[2 * 33], s[3 * 33]); o.z = pk2(s[4 * 33], s[5 * 33]); o.w = pk2(s[6 * 33], s[7 * 33]);
        *(GAS v4u*)(WT + (size_t)(drow0 + n) * K + k0 + 8 * c) = o; }
    LDS_WAIT(); asm volatile("" ::: "memory");
}
__device__ __forceinline__ int win_row(int n) { if (n < 512) return 256 * (n >> 7) + (n & 127); if (n < 1024) { const int c = n - 512; return 256 * (c >> 7) + 128 + (c & 127); } return n; }

__device__ __forceinline__ void rms_row_to_bf16(const float* xrow, const float* g, bf16* orow, int lane) {
    const GAS f32x4* xr = (const GAS f32x4*)xrow + lane; const GAS f32x4* gr = (const GAS f32x4*)g + lane;
    f32x4 v[4]; float s = 0.f;
#pragma unroll
    for (int j = 0; j < 4; ++j) { v[j] = xr[64 * j]; s += (v[j].x * v[j].x + v[j].y * v[j].y) + (v[j].z * v[j].z + v[j].w * v[j].w); }
    const float r = 1.0f / sqrtf(wave_sum(s) * (1.f / 1024.f) + RMS_EPS);
    GAS unsigned long long* o8 = (GAS unsigned long long*)orow + lane;
#pragma unroll
    for (int j = 0; j < 4; ++j) { const f32x4 gg = gr[64 * j]; o8[64 * j] = (unsigned long long)pk2(v[j].x * r * gg.x, v[j].y * r * gg.y) | ((unsigned long long)pk2(v[j].z * r * gg.z, v[j].w * r * gg.w) << 32); }
}
__device__ __forceinline__ void spool_item(Frame& F, int item) {
    const int bs = item >> 6, c = item & 63, lane = F.lane;
    const int page = F.page_table[bs * 16 + (c >> 2)], row0 = (c & 3) * 32;
    const float* src = F.cache_kv + ((size_t)page * 128 + row0) * 512 + lane * 4;
    const float* w = (lane < 32 ? F.w_ck : F.w_cv) + ((lane >> 4) & 1);
    f32x4 acc = (f32x4){0.f, 0.f, 0.f, 0.f};
    f32x4 v[32]; float wj[32];
#pragma unroll
    for (int j = 0; j < 32; ++j) { v[j] = __builtin_nontemporal_load((const f32x4*)(src + (size_t)j * 512)); wj[j] = w[j * 2]; }
#pragma unroll
    for (int j = 0; j < 32; ++j) acc += v[j] * wj[j];
    *(f32x4*)(F.KCVS + ((size_t)bs * 64 + c) * 256 + lane * 4) = acc;
}
__device__ __forceinline__ void p0_prologue(Frame& F) {
    LAS float* scr = (LAS float*)(F.lds + RING_OFF + F.wave * 16384);
    const int gw = F.vcu * NWAVES + F.wave, NGW = F.G * NWAVES;
    constexpr int NB_IN = 73;
    constexpr int I_IN = (D / 64) * NB_IN, I_OUT = (D / 64) * (D / 32), I_UP = (D / 64) * (FF / 32), I_DN = (FF / 64) * (D / 32);
    constexpr int NITEMS = I_IN + I_OUT + I_UP + I_DN;
    for (int it = gw; it < NITEMS; it += NGW) {
        int r = it;
        if (r < I_IN) { const int kb = r / NB_IN, nb = r % NB_IN; p0_transpose_item(F.w_in, D, NIN, F.Win_t, 64 * kb, 32 * nb, win_row(32 * nb), scr, F.lane); continue; } r -= I_IN;
        if (r < I_OUT) { const int kb = r / (D / 32), nb = r % (D / 32); p0_transpose_item(F.w_out, D, D, F.Wout_t, 64 * kb, 32 * nb, 32 * nb, scr, F.lane); continue; } r -= I_OUT;
        if (r < I_UP) { const int kb = r / (FF / 32), nb = r % (FF / 32); p0_transpose_item(F.w_up, D, FF, F.Wup_t, 64 * kb, 32 * nb, 32 * nb, scr, F.lane); continue; } r -= I_UP;
        { const int kb = r / (D / 32), nb = r % (D / 32); p0_transpose_item(F.w_down, FF, D, F.Wdn_t, 64 * kb, 32 * nb, 32 * nb, scr, F.lane); }
    }
    for (int rr = gw; rr < NINP - 2336; rr += NGW) { GAS v4u* o = (GAS v4u*)(F.Win_t + (size_t)(2336 + rr) * D) + F.lane; o[0] = (v4u){0u, 0u, 0u, 0u}; o[64] = (v4u){0u, 0u, 0u, 0u}; }
    for (int m = gw; m < MALL; m += NGW) {
        if (m < MP) rms_row_to_bf16(F.x_prompt + (size_t)m * D, F.g_attn, F.XN + (size_t)m * D, F.lane);
        else if (m < NVALID) rms_row_to_bf16(F.x_sample + (size_t)(m - MP) * D, F.g_attn, F.XN + (size_t)m * D, F.lane);
        else { GAS v4u* o = (GAS v4u*)(F.XN + (size_t)m * D) + F.lane; o[0] = (v4u){0u, 0u, 0u, 0u}; o[64] = (v4u){0u, 0u, 0u, 0u}; }
    }
}

__device__ __forceinline__ void spool_drain(Frame& F) {
    LAS unsigned* QS = (LAS unsigned*)(F.lds + RING_OFF);
    unsigned mine = 0u;
    if (F.tid == 0) QS[0] = __hip_atomic_fetch_add((unsigned*)(F.ctl + CW_SPOOL), 8u, __ATOMIC_RELAXED, __HIP_MEMORY_SCOPE_AGENT);
    __syncthreads();
    for (;;) {
        const unsigned it = QS[0];
        if (it >= (unsigned)(MS * 64)) break;
        if (F.tid == 0) mine = __hip_atomic_fetch_add((unsigned*)(F.ctl + CW_SPOOL), 8u, __ATOMIC_RELAXED, __HIP_MEMORY_SCOPE_AGENT);
        spool_item(F, (int)it + F.wave);
        __syncthreads();
        if (F.tid == 0) QS[0] = mine;
        __syncthreads();
    }
}
__device__ __forceinline__ void conv_unit(Frame& F, int unit) {
    const int b = unit >> 6, t0 = (unit & 63) * 32, tg = F.wave >> 2, cq = F.wave & 3, lane = F.lane;
    const int ch = cq * 128 + 2 * lane, tbase = t0 + 16 * tg;
    float w0[31], w1[31];
#pragma unroll
    for (int j = 0; j < 31; ++j) { const float2 wv = *(const float2*)(F.w_dw + j * 512 + ch); w0[j] = wv.x; w1[j] = wv.y; }
    unsigned xr[46];
#pragma unroll
    for (int r = 0; r < 46; ++r) { const int tr = tbase - 30 + r; const int trc = tr < 0 ? 0 : tr; xr[r] = *(const unsigned*)(F.Gb + ((size_t)(b * SEQ + trc)) * 512 + ch); }
#pragma unroll
    for (int r = 0; r < 30; ++r) { if (tbase - 30 + r < 0) xr[r] = 0u; }
    const float2 bd = *(const float2*)(F.b_dw + ch);
    float a0[16], a1[16];
#pragma unroll
    for (int i = 0; i < 16; ++i) { a0[i] = bd.x; a1[i] = bd.y; }
#pragma unroll
    for (int r = 0; r < 46; ++r) { const float x0 = __uint_as_float(xr[r] << 16), x1 = __uint_as_float(xr[r] & 0xffff0000u);
#pragma unroll
        for (int i = 0; i < 16; ++i) { const int j = r - i; if (j >= 0 && j <= 30) { a0[i] += x0 * w0[j]; a1[i] += x1 * w1[j]; } } }
    typedef float f32x2v __attribute__((ext_vector_type(2)));
    LAS f32x2v* RED = (LAS f32x2v*)(F.lds + RING_OFF);
    LAS f32x2v* STAT = (LAS f32x2v*)(F.lds + RING_OFF + 73728);
#pragma unroll
    for (int i = 0; i < 16; ++i) RED[(tg * 16 + i) * 272 + cq * 64 + lane] = (f32x2v){a0[i] + a1[i], a0[i] * a0[i] + a1[i] * a1[i]};
    __syncthreads();
    { const int tk = F.tid >> 4, p = F.tid & 15; float s = 0.f, q = 0.f;
#pragma unroll
      for (int e = 0; e < 16; ++e) { const f32x2v v = RED[tk * 272 + e * 16 + p]; s += v.x; q += v.y; }
#pragma unroll
      for (int o = 1; o < 16; o <<= 1) { s += __shfl_xor(s, o); q += __shfl_xor(q, o); }
      if (p == 0) { const float mu = s * (1.f / 512.f); const float var = fmaxf(q * (1.f / 512.f) - mu * mu, 0.f); STAT[tk] = (f32x2v){mu, 1.0f / sqrtf(var + LN_EPS)}; } }
    __syncthreads();
    const float2 lg = *(const float2*)(F.ln_g + ch), lb = *(const float2*)(F.ln_b + ch);
#pragma unroll
    for (int i = 0; i < 16; ++i) { const f32x2v st = STAT[tg * 16 + i];
        const float y0 = (a0[i] - st.x) * st.y * lg.x + lb.x, y1 = (a1[i] - st.x) * st.y * lg.y + lb.y;
        *(unsigned*)(F.AO + ((size_t)(b * SEQ + tbase + i)) * D + ch) = pk2(y0 * sigmoidf_(y0), y1 * sigmoidf_(y1)); }
    __syncthreads();
}
__device__ __forceinline__ void sconv_unit(Frame& F, int bs) {
    const int c = F.tid;
    const float* st = F.state_conv + (size_t)bs * 30 * 512 + c;
    float* oc = F.out + O_CONVS + (size_t)bs * 30 * 512 + c;
    float sv[31], wv[31];
#pragma unroll
    for (int j = 0; j < 30; ++j) sv[j] = st[j * 512];
    sv[30] = oc[29 * 512];
#pragma unroll
    for (int j = 0; j < 31; ++j) wv[j] = F.w_dw[j * 512 + c];
    float a = F.b_dw[c];
#pragma unroll
    for (int j = 0; j < 31; ++j) a += sv[j] * wv[j];
#pragma unroll
    for (int j = 1; j < 30; ++j) oc[(j - 1) * 512] = sv[j];
    LAS float* RS = (LAS float*)(F.lds + RING_OFF);
    const float s = wave_sum(a), q = wave_sum(a * a);
    if (F.lane == 0) { RS[F.wave] = s; RS[8 + F.wave] = q; }
    __syncthreads();
    float ts = 0.f, tq = 0.f;
#pragma unroll
    for (int w = 0; w < 8; ++w) { ts += RS[w]; tq += RS[8 + w]; }
    const float mu = ts * (1.f / 512.f); const float var = fmaxf(tq * (1.f / 512.f) - mu * mu, 0.f); const float rstd = 1.0f / sqrtf(var + LN_EPS);
    const float y = (a - mu) * rstd * F.ln_g[c] + F.ln_b[c];
    F.AO[(size_t)(MP + bs) * D + c] = (bf16)f2bf(y * sigmoidf_(y));
    __syncthreads();
}
__device__ __forceinline__ void ppool_item(Frame& F, int item) {
    const int b = item >> 6, c = item & 63, lane = F.lane;
    const bf16* src = F.KVb + ((size_t)(b * SEQ + c * 32)) * 768 + lane * 4;
    const float* w = (lane < 32 ? F.w_ck : F.w_cv) + ((lane >> 4) & 1);
    float a[4] = {0.f, 0.f, 0.f, 0.f};
    unsigned long long vv[32];
#pragma unroll
    for (int j = 0; j < 32; ++j) vv[j] = *(const unsigned long long*)(src + (size_t)j * 768);
#pragma unroll
    for (int j = 0; j < 32; ++j) { const unsigned long long v = vv[j]; const float wj = w[j * 2];
        a[0] += bf2f((unsigned short)v) * wj; a[1] += bf2f((unsigned short)(v >> 16)) * wj; a[2] += bf2f((unsigned short)(v >> 32)) * wj; a[3] += bf2f((unsigned short)(v >> 48)) * wj; }
    const int h = (lane >> 4) & 1, d = (lane & 15) * 4;
    bf16* dst = (lane < 32 ? F.KCP : F.VCP) + ((size_t)((b * 2 + h) * 64 + c)) * 64 + d;
    *(unsigned long long*)dst = (unsigned long long)pk2(a[0], a[1]) | ((unsigned long long)pk2(a[2], a[3]) << 32);
}
__device__ __forceinline__ void p2_phase(Frame& F) {
    if (F.wave < 2) { for (int it = F.vcu * 2 + F.wave; it < NB * 64; it += F.G * 2) ppool_item(F, it); }
    for (int u = F.vcu; u < MS; u += F.G) sconv_unit(F, u);
    for (int u = F.G - 1 - F.vcu; u < MP / 32; u += F.G) conv_unit(F, u);
}

__device__ __forceinline__ pg8::f32x4 skinny_tile(LAS unsigned char* lds, const bf16* A, int lda, const bf16* Bt, int ldb, int n0, int k0, int wave, int lane) {
    const bf16* ap = A + (size_t)(lane & 15) * lda + k0 + 128 * wave + 8 * (lane >> 4);
    const bf16* bp = Bt + (size_t)(n0 + (lane & 15)) * ldb + k0 + 128 * wave + 8 * (lane >> 4);
    bf16x8 b[4], a[8][4];
#pragma unroll
    for (int s = 0; s < 4; ++s) b[s] = *(const bf16x8*)(bp + s * 32);
#pragma unroll
    for (int rb = 0; rb < 8; ++rb)
#pragma unroll
        for (int s = 0; s < 4; ++s) a[rb][s] = *(const bf16x8*)(ap + (size_t)(16 * rb) * lda + s * 32);
    LAS pg8::f32x4* RED = (LAS pg8::f32x4*)lds;
#pragma unroll
    for (int rb = 0; rb < 8; ++rb) { pg8::f32x4 acc = (pg8::f32x4){0.f, 0.f, 0.f, 0.f};
#pragma unroll
        for (int s = 0; s < 4; ++s) acc = __builtin_amdgcn_mfma_f32_16x16x32_bf16(a[rb][s], b[s], acc, 0, 0, 0);
        RED[(wave * 8 + rb) * 64 + lane] = acc; }
    __syncthreads();
    pg8::f32x4 r = RED[wave * 64 + lane];
#pragma unroll
    for (int w = 1; w < 8; ++w) r += RED[(w * 8 + wave) * 64 + lane];
    __syncthreads();
    return r;
}
__device__ __forceinline__ void s_outproj_item(Frame& F, int item) {
    const int n0 = item * 16, lane = F.lane, col = n0 + (lane & 15);
    const pg8::f32x4 acc = skinny_tile(F.lds + RING_OFF, F.AO + (size_t)MP * D, D, F.Wout_t, D, n0, 0, F.wave, lane);
    const float g = F.g_mlp[col];
#pragma unroll
    for (int i = 0; i < 4; ++i) { const int row = 16 * F.wave + 4 * (lane >> 4) + i; const float hv = F.x_sample[(size_t)row * D + col] + acc[i];
        F.out[O_YS + (size_t)row * D + col] = hv; F.HB[(size_t)(MP + row) * D + col] = (bf16)f2bf(hv * g);
        float s = hv * hv; s += __shfl_xor(s, 1); s += __shfl_xor(s, 2); s += __shfl_xor(s, 4); s += __shfl_xor(s, 8);
        if ((lane & 15) == 0) atomicAdd(F.SS1 + MP + row, s); }
}
__device__ __forceinline__ void s_up_item(Frame& F, int item) {
    const int n0 = item * 16, lane = F.lane, col = n0 + (lane & 15);
    const pg8::f32x4 acc = skinny_tile(F.lds + RING_OFF, F.HB + (size_t)MP * D, D, F.Wup_t, D, n0, 0, F.wave, lane);
#pragma unroll
    for (int i = 0; i < 4; ++i) { const int row = 16 * F.wave + 4 * (lane >> 4) + i; const float r = __builtin_amdgcn_rsqf(F.SS1[MP + row] * (1.f / 1024.f) + RMS_EPS);
        const float v = fmaxf(acc[i] * r, 0.f); F.MID[(size_t)(MP + row) * FF + col] = (bf16)f2bf(v * v); }
}
__device__ __forceinline__ void s_down_item(Frame& F, int item) {
    const int n0 = (item & 63) * 16, kq = item >> 6, lane = F.lane, col = n0 + (lane & 15);
    const pg8::f32x4 acc = skinny_tile(F.lds + RING_OFF, F.MID + (size_t)MP * FF, FF, F.Wdn_t, FF, n0, kq * 1024, F.wave, lane);
#pragma unroll
    for (int i = 0; i < 4; ++i) { const int row = 16 * F.wave + 4 * (lane >> 4) + i; atomicAdd(F.DACC + (size_t)row * D + col, acc[i]); }
}
__device__ __forceinline__ void p7_phase(Frame& F, float* ydst_p, float* ydst_s) {
    const int gw = F.vcu * NWAVES + F.wave, NGW = F.G * NWAVES, lane = F.lane;
    const GAS f32x4* gr = (const GAS f32x4*)F.g_final + lane;
    f32x4 gg[4];
#pragma unroll
    for (int j = 0; j < 4; ++j) gg[j] = gr[64 * j];
    for (int m = gw; m < MS; m += NGW) {
        GAS f32x4* yr = (GAS f32x4*)(F.out + O_YS + (size_t)m * D) + lane; const GAS f32x4* dr = (const GAS f32x4*)(F.DACC + (size_t)m * D) + lane;
        f32x4 v[4]; float s = 0.f;
#pragma unroll
        for (int j = 0; j < 4; ++j) { v[j] = yr[64 * j] + dr[64 * j]; s += (v[j].x * v[j].x + v[j].y * v[j].y) + (v[j].z * v[j].z + v[j].w * v[j].w); }
        const float r = 1.0f / sqrtf(wave_sum(s) * (1.f / 1024.f) + RMS_EPS);
        GAS f32x4* yw = (GAS f32x4*)(ydst_s + (size_t)m * D) + lane;
#pragma unroll
        for (int j = 0; j < 4; ++j) yw[64 * j] = v[j] * r * gg[j];
    }
    for (int m = gw; m < MP; m += NGW) {
        GAS f32x4* yr = (GAS f32x4*)(F.out + O_YP + (size_t)m * D) + lane;
        const float r = 1.0f / sqrtf(F.SS2[m] * (1.f / 1024.f) + RMS_EPS);
        f32x4 v[4];
#pragma unroll
        for (int j = 0; j < 4; ++j) v[j] = yr[64 * j];
        GAS f32x4* yw = (GAS f32x4*)(ydst_p + (size_t)m * D) + lane;
#pragma unroll
        for (int j = 0; j < 4; ++j) yw[64 * j] = v[j] * r * gg[j];
    }
}

namespace att {
typedef short bf16x8 __attribute__((ext_vector_type(8)));
typedef short s16x4 __attribute__((ext_vector_type(4)));
typedef float f32x16 __attribute__((ext_vector_type(16)));
typedef unsigned u32x4 __attribute__((ext_vector_type(4)));
typedef float f32x2_t __attribute__((ext_vector_type(2))); typedef __bf16 bf16x2_t __attribute__((ext_vector_type(2)));
#define ALAS __attribute__((address_space(3)))
constexpr int A_K = 0, A_V = 24576, A_WS = 49152, A_PBLK = 51200, A_SELM = 59648, A_OST = 59904, A_QSLOT = 125440, A_BON = 125504, A_END = 125632;
constexpr int S_SC = 0, S_PH = 1024, S_PBL = 2048, S_SEL = 2304, S_ML = 2560, S_MO = 3072, S_RES = 11264, S_END = 14336;
constexpr float NEGINF = -INFINITY, MINIT = -1e30f, THR = 8.0f;

__device__ __forceinline__ int crow(int r, int hi) { return (r & 3) + 8 * (r >> 2) + 4 * hi; }
__device__ __forceinline__ unsigned cvtpk_s(float lo, float hi) { f32x2_t v = {lo, hi}; bf16x2_t b = __builtin_convertvector(v, bf16x2_t); return __builtin_bit_cast(unsigned, b); }
__device__ __forceinline__ float sum_halves(float v) { auto rr = __builtin_amdgcn_permlane32_swap(__float_as_uint(v), __float_as_uint(v), false, false); return __uint_as_float(rr[0]) + __uint_as_float(rr[1]); }

__device__ __forceinline__ void qk_tile(f32x16& p0, f32x16& p1, const ALAS char* kslot, const bf16x8 (&qr)[4], int r32, int hi) {
    const ALAS char* kb = kslot + hi * 1024 + r32 * 16;
    p0 = (f32x16){}; p1 = (f32x16){};
#pragma unroll
    for (int d0 = 0; d0 < 4; ++d0) {
        const bf16x8 b0 = *(const ALAS bf16x8*)(kb + d0 * 2048), b1 = *(const ALAS bf16x8*)(kb + d0 * 2048 + 512);
        p0 = __builtin_amdgcn_mfma_f32_32x32x16_bf16(b0, qr[d0], p0, 0, 0, 0); p1 = __builtin_amdgcn_mfma_f32_32x32x16_bf16(b1, qr[d0], p1, 0, 0, 0); }
}
__device__ __forceinline__ void pv_tile(f32x16 (&o)[2], unsigned vb, bf16x8 pa0, bf16x8 pa1, bf16x8 pa2, bf16x8 pa3) {
#pragma unroll
    for (int d0 = 0; d0 < 2; ++d0) { s16x4 lo[4], hi[4];
#pragma unroll
        for (int ks = 0; ks < 4; ++ks) {
            asm volatile("ds_read_b64_tr_b16 %0,%1 offset:%c2" : "=&v"(lo[ks]) : "v"(vb), "i"(d0 * 4096 + ks * 1024) : "memory");
            asm volatile("ds_read_b64_tr_b16 %0,%1 offset:%c2" : "=&v"(hi[ks]) : "v"(vb), "i"(d0 * 4096 + ks * 1024 + 512) : "memory"); }
        asm volatile("s_waitcnt lgkmcnt(0)" ::: "memory"); __builtin_amdgcn_sched_barrier(0);
#define ATT_PK(k) (bf16x8){lo[k][0], lo[k][1], lo[k][2], lo[k][3], hi[k][0], hi[k][1], hi[k][2], hi[k][3]}
        o[d0] = __builtin_amdgcn_mfma_f32_32x32x16_bf16(pa0, ATT_PK(0), o[d0], 0, 0, 0);
        o[d0] = __builtin_amdgcn_mfma_f32_32x32x16_bf16(pa1, ATT_PK(1), o[d0], 0, 0, 0);
        o[d0] = __builtin_amdgcn_mfma_f32_32x32x16_bf16(pa2, ATT_PK(2), o[d0], 0, 0, 0);
        o[d0] = __builtin_amdgcn_mfma_f32_32x32x16_bf16(pa3, ATT_PK(3), o[d0], 0, 0, 0);
#undef ATT_PK
    }
}
__device__ __forceinline__ float rowmax32(const f32x16& p0, const f32x16& p1) {
    float a = fmaxf(p0[0], p1[0]);
#pragma unroll
    for (int r = 1; r < 16; ++r) a = fmaxf(a, fmaxf(p0[r], p1[r]));
    auto rr = __builtin_amdgcn_permlane32_swap(__float_as_uint(a), __float_as_uint(a), false, false);
    return fmaxf(__uint_as_float(rr[0]), __uint_as_float(rr[1]));
}
struct SoftState { float m, l; };
__device__ __forceinline__ void softmax_step(f32x16& p0, f32x16& p1, SoftState& st, f32x16 (&o)[2], ALAS float* wsf, int r32, int hi) {
    const float rm = rowmax32(p0, p1);
    if (__any(rm > st.m + THR)) {
        const float mn = fmaxf(st.m, rm); const float alpha = __builtin_amdgcn_exp2f(st.m - mn); st.m = mn; st.l *= alpha;
        if (hi == 0) wsf[r32] = alpha;
        asm volatile("s_waitcnt lgkmcnt(0)" ::: "memory");
#pragma unroll
        for (int r = 0; r < 16; ++r) { const float f = wsf[crow(r, hi)]; o[0][r] *= f; o[1][r] *= f; }
    }
    float s = 0.f;
#pragma unroll
    for (int r = 0; r < 16; ++r) { p0[r] = __builtin_amdgcn_exp2f(p0[r] - st.m); p1[r] = __builtin_amdgcn_exp2f(p1[r] - st.m); s += p0[r] + p1[r]; }
    st.l += s;
}
__device__ __forceinline__ void pv_from_p(f32x16 (&o)[2], const f32x16& p0, const f32x16& p1, unsigned vb) {
    u32x4 w0, w1, w2, w3;
    w0 = (u32x4){cvtpk_s(p0[0], p0[1]), cvtpk_s(p0[2], p0[3]), cvtpk_s(p0[4], p0[5]), cvtpk_s(p0[6], p0[7])};
    w1 = (u32x4){cvtpk_s(p0[8], p0[9]), cvtpk_s(p0[10], p0[11]), cvtpk_s(p0[12], p0[13]), cvtpk_s(p0[14], p0[15])};
    w2 = (u32x4){cvtpk_s(p1[0], p1[1]), cvtpk_s(p1[2], p1[3]), cvtpk_s(p1[4], p1[5]), cvtpk_s(p1[6], p1[7])};
    w3 = (u32x4){cvtpk_s(p1[8], p1[9]), cvtpk_s(p1[10], p1[11]), cvtpk_s(p1[12], p1[13]), cvtpk_s(p1[14], p1[15])};
    pv_tile(o, vb, __builtin_bit_cast(bf16x8, w0), __builtin_bit_cast(bf16x8, w1), __builtin_bit_cast(bf16x8, w2), __builtin_bit_cast(bf16x8, w3));
}
template <bool FIRST> __device__ __forceinline__ void fold_branch(ALAS float* stg, const f32x16 (&o)[2], float fq, ALAS float* wsf, int r32, int hi) {
    if (hi == 0) wsf[r32] = fq;
    asm volatile("s_waitcnt lgkmcnt(0)" ::: "memory");
    ALAS float* sp = stg + hi * 256 + r32;
#pragma unroll
    for (int r = 0; r < 16; ++r) { const float f = wsf[4 * hi + (r & 3) + 8 * (r >> 2)]; const int ro = ((r & 3) + 8 * (r >> 2)) * 64;
        if (FIRST) { sp[ro] = o[0][r] * f; sp[ro + 32] = o[1][r] * f; } else { sp[ro] += o[0][r] * f; sp[ro + 32] += o[1][r] * f; } }
}

__device__ __forceinline__ float max3f(float a, float b, float c) { float r; asm("v_max3_f32 %0, %1, %2, %3" : "=v"(r) : "v"(a), "v"(b), "v"(c)); return r; }
__device__ __forceinline__ float rowmax32a(const f32x16& p0, const f32x16& p1) {
    float a = max3f(p0[0], p0[1], p1[0]), b = max3f(p0[2], p0[3], p1[1]); a = max3f(a, p1[2], p1[3]);
#pragma unroll
    for (int r = 4; r < 16; r += 4) { a = max3f(a, p0[r], p0[r + 1]); b = max3f(b, p0[r + 2], p0[r + 3]); a = max3f(a, p1[r], p1[r + 1]); b = max3f(b, p1[r + 2], p1[r + 3]); }
    const float m = fmaxf(a, b);
    auto rr = __builtin_amdgcn_permlane32_swap(__float_as_uint(m), __float_as_uint(m), false, false);
    return fmaxf(__uint_as_float(rr[0]), __uint_as_float(rr[1]));
}
__device__ __forceinline__ void qk_tile_c(f32x16& p0, f32x16& p1, const ALAS char* kslot, const bf16x8 (&qr)[4], const f32x16& cinit, int r32, int hi) {
    const ALAS char* kb = kslot + hi * 1024 + r32 * 16;
    bf16x8 b0[4], b1[4];
#pragma unroll
    for (int d0 = 0; d0 < 4; ++d0) { b0[d0] = *(const ALAS bf16x8*)(kb + d0 * 2048); b1[d0] = *(const ALAS bf16x8*)(kb + d0 * 2048 + 512); }
    p0 = __builtin_amdgcn_mfma_f32_32x32x16_bf16(b0[0], qr[0], cinit, 0, 0, 0); p1 = __builtin_amdgcn_mfma_f32_32x32x16_bf16(b1[0], qr[0], cinit, 0, 0, 0);
#pragma unroll
    for (int d0 = 1; d0 < 4; ++d0) { p0 = __builtin_amdgcn_mfma_f32_32x32x16_bf16(b0[d0], qr[d0], p0, 0, 0, 0); p1 = __builtin_amdgcn_mfma_f32_32x32x16_bf16(b1[d0], qr[d0], p1, 0, 0, 0); }
}
template <int ABL> __device__ __forceinline__ void prompt_unit(Frame& F, int b, int h, int qb) {
    if (ABL == 7) return;
    frame_fill(F);
    int tid = F.tid; asm volatile("" : "+v"(tid));
    const int lane = tid & 63, wid = F.wave, r32 = lane & 31, hi = lane >> 5, g = wid >> 1, qh = wid & 1;
    ALAS char* L = (ALAS char*)F.lds;
    ALAS float* wsf = (ALAS float*)(L + A_WS) + wid * 64;
    ALAS float* PB4 = (ALAS float*)(L + A_OST);
    ALAS unsigned* SELM = (ALAS unsigned*)(L + A_SELM);
    ALAS float* BON = (ALAS float*)(L + A_BON);
    ALAS float* stg = (ALAS float*)(L + A_OST) + wid * 2048;
    const int head = 4 * h + g, rowb = b * SEQ, q0 = qb * 64, qi = 32 * qh + r32;
    const size_t qrow = (size_t)(rowb + q0 + qi);
    const int krow = tid & 63, kch = tid >> 6;
    const int vrow = 16 * (wid & 3) + (lane >> 2), vcol = (wid >> 2) * 32 + (lane & 3) * 8;
    const bf16* KVh = F.KVb + (size_t)rowb * 768 + h * 64;
    const bf16* kcb = F.KCP + (size_t)((b * 2 + h) * 64) * 64; const bf16* vcb = F.VCP + (size_t)((b * 2 + h) * 64) * 64;
    const unsigned vb0 = (unsigned)(uintptr_t)(L + A_V) + ((lane >> 4) & 1) * 32 + (lane & 3) * 8 + (4 * hi + ((lane & 15) >> 2)) * 64;
    const int nsel = qb + 1, tw0 = (qb >= 8) ? qb - 8 : 0, T = 1 + nsel + (qb - tw0 + 1);
    u32x4 kreg, vreg;
#define LOAD_SEQ(s) do { const int s_ = (s); if (s_ == 0) { kreg = *(const u32x4*)(kcb + krow * 64 + kch * 8); vreg = *(const u32x4*)(vcb + vrow * 64 + vcol); } \
        else { const int t_ = (s_ <= nsel) ? s_ - 1 : tw0 + (s_ - nsel - 1); const int c_ = (s_ <= nsel) ? 256 : 512; \
               kreg = *(const u32x4*)(KVh + (size_t)(64 * t_ + krow) * 768 + c_ + kch * 8); vreg = *(const u32x4*)(KVh + (size_t)(64 * t_ + vrow) * 768 + c_ + 128 + vcol); } } while (0)
#define STORE_SLOT(slotb) do { *(ALAS u32x4*)(L + A_K + (slotb) + tid * 16) = kreg; *(ALAS u32x4*)(L + A_V + (slotb) + tid * 16) = vreg; } while (0)
    LOAD_SEQ(0);
    if (tid < 32) BON[tid] = (tid <= qb) ? ((tid == 0 || tid + 1 >= qb) ? 5.0f : 0.f) : NEGINF;
    bf16x8 qr[4];
#pragma unroll
    for (int d0 = 0; d0 < 4; ++d0) qr[d0] = *(const bf16x8*)(F.Qb + qrow * 512 + head * 64 + d0 * 16 + hi * 8);
    const float g_cmp = F.GATE[qrow * 32 + head * 3 + 0], g_sel = F.GATE[qrow * 32 + head * 3 + 1], g_win = F.GATE[qrow * 32 + head * 3 + 2];
    STORE_SLOT(0);
    LOAD_SEQ(1);
    __syncthreads();
    if (ABL == 9) { asm volatile("" :: "v"(kreg), "v"(vreg), "v"(qr[0]), "v"(qr[1]), "v"(qr[2]), "v"(qr[3]), "v"(g_cmp), "v"(g_sel), "v"(g_win)); return; }
    f32x16 o[2], p0, p1, cini; float fcmp = 0.f;
    STORE_SLOT(8192);
    LOAD_SEQ(2);
    if (ABL != 10) {
        cini = (f32x16){};
        qk_tile_c(p0, p1, L + A_K, qr, cini, r32, hi);
        int nv = ((q0 + qi + 1) >> 5) - 4 * hi; asm volatile("" : "+v"(nv));
#pragma unroll
        for (int r = 0; r < 16; ++r) { const int c = (r & 3) + 8 * (r >> 2); if (c >= nv) p0[r] = NEGINF; if (c + 32 >= nv) p1[r] = NEGINF; }
        const float rm = rowmax32a(p0, p1); const float m = (rm == NEGINF) ? 0.f : rm;
        float s = 0.f;
#pragma unroll
        for (int r = 0; r < 16; ++r) { p0[r] = __builtin_amdgcn_exp2f(p0[r] - m); p1[r] = __builtin_amdgcn_exp2f(p1[r] - m); s += p0[r] + p1[r]; }
        s = sum_halves(s);
        const float inv = (s > 0.f) ? 1.0f / s : 0.f;
#pragma unroll
        for (int k = 0; k < 8; ++k) { const int blk = 4 * (k >> 1) + 2 * hi + (k & 1);
            PB4[(g * 64 + qi) * 33 + blk] = (p0[2 * k] + p0[2 * k + 1]) * inv; PB4[(g * 64 + qi) * 33 + blk + 16] = (p1[2 * k] + p1[2 * k + 1]) * inv; }
        o[0] = (f32x16){}; o[1] = (f32x16){};
        pv_from_p(o, p0, p1, vb0);
        fcmp = g_cmp * inv;
    }
    __syncthreads();
    if (ABL != 8) {
        const int q = tid >> 3, part = tid & 7;
        int key[32];
#pragma unroll
        for (int j = 0; j < 32; ++j) { const float imp = (PB4[q * 33 + j] + PB4[(64 + q) * 33 + j]) + (PB4[(128 + q) * 33 + j] + PB4[(192 + q) * 33 + j]);
            key[j] = (int)((__float_as_uint(imp + BON[j]) & ~31u) | (unsigned)(31 - j)); }
        unsigned bits = 0u;
#pragma unroll
        for (int ii = 0; ii < 4; ++ii) { const int i = part * 4 + ii; int ki = key[0];
#pragma unroll
            for (int j = 1; j < 32; ++j) ki = (j == i) ? key[j] : ki;
            unsigned rank = 0u;
#pragma unroll
            for (int j = 0; j < 32; ++j) rank += (unsigned)(ki - key[j]) >> 31;
            if (rank < 16u) bits |= 1u << i; }
        bits |= __shfl_xor(bits, 1); bits |= __shfl_xor(bits, 2); bits |= __shfl_xor(bits, 4);
        if (part == 0) SELM[q] = bits;
    }
    __syncthreads();
    const unsigned selm = SELM[qi];
    fold_branch<true>(stg, o, fcmp, wsf, r32, hi);
    float mref = 0.f, lsum = 0.f; o[0] = (f32x16){}; o[1] = (f32x16){};
    int sl_cur = 8192, sl_nxt = 16384;
    for (int s = 1; s < ((ABL == 6 || ABL == 8) ? 1 : T); ++s) {
        if (ABL != 2 && ABL != 5) { if (s + 1 < T) STORE_SLOT(sl_nxt);
        if (s + 2 < T) LOAD_SEQ(s + 2); }
        const bool in_sel = s <= nsel; const int t = in_sel ? s - 1 : tw0 + (s - nsel - 1);
        const bool first = (s == 1) || (s == nsel + 1);
        if (s == nsel + 1) { mref = 0.f; lsum = 0.f; o[0] = (f32x16){}; o[1] = (f32x16){}; }
        const bool act = in_sel ? (((selm >> t) & 1u) != 0u) : true;
        if (ABL != 1 && __any(act)) {
            { const float cv = act ? -mref : NEGINF;
#pragma unroll
              for (int r = 0; r < 16; ++r) cini[r] = cv; }
            qk_tile_c(p0, p1, L + A_K + sl_cur, qr, cini, r32, hi);
            if (t == qb) { int xq = qi - 4 * hi; asm volatile("" : "+v"(xq));
#pragma unroll
                for (int r = 0; r < 16; ++r) { const int j = (r & 3) + 8 * (r >> 2); if (j > xq) p0[r] = NEGINF; if (j + 32 > xq) p1[r] = NEGINF; } }
            if (!in_sel && t + 8 == qb) { int xq = qi - 4 * hi; asm volatile("" : "+v"(xq));
#pragma unroll
                for (int r = 0; r < 16; ++r) { const int j = (r & 3) + 8 * (r >> 2); if (j < xq) p0[r] = NEGINF; if (j + 32 < xq) p1[r] = NEGINF; } }
            const float rm = rowmax32a(p0, p1);
            if (first || __any(rm > THR)) {
                const float d = first ? rm : fmaxf(rm, 0.f); mref += d; const float alpha = __builtin_amdgcn_exp2f(-d); lsum *= alpha;
#pragma unroll
                for (int r = 0; r < 16; ++r) { p0[r] -= d; p1[r] -= d; }
                if (!first) { if (hi == 0) wsf[r32] = alpha; asm volatile("s_waitcnt lgkmcnt(0)" ::: "memory");
#pragma unroll
                    for (int r = 0; r < 16; ++r) { const float f = wsf[4 * hi + (r & 3) + 8 * (r >> 2)]; o[0][r] *= f; o[1][r] *= f; } }
            }
            float sa = 0.f, sb = 0.f;
#pragma unroll
            for (int r = 0; r < 16; ++r) { if (ABL != 4) { p0[r] = __builtin_amdgcn_exp2f(p0[r]); p1[r] = __builtin_amdgcn_exp2f(p1[r]); } sa += p0[r]; sb += p1[r]; }
            lsum += sa + sb;
            if (ABL != 3) pv_from_p(o, p0, p1, vb0 + sl_cur); else { asm volatile("" :: "v"(p0), "v"(p1)); }
        }
        if (s == nsel) { const float lt = sum_halves(lsum); fold_branch<false>(stg, o, g_sel / lt, wsf, r32, hi); }
        if (s == T - 1) { const float lt = sum_halves(lsum); fold_branch<false>(stg, o, g_win / lt, wsf, r32, hi); }
        if (ABL != 5) __syncthreads();
        sl_cur = sl_nxt; sl_nxt = (sl_nxt == 16384) ? 0 : sl_nxt + 8192;
    }
#undef LOAD_SEQ
#undef STORE_SLOT
    {
        asm volatile("s_waitcnt lgkmcnt(0)" ::: "memory");
        bf16* Ow = F.AO + (size_t)(rowb + q0 + 32 * qh) * D + 512 + head * 64;
#pragma unroll
        for (int i = 0; i < 4; ++i) { const int row = i * 8 + (lane >> 3), ch = lane & 7; const ALAS pg8::f32x4* sp = (const ALAS pg8::f32x4*)(stg + row * 64 + ch * 8);
            const pg8::f32x4 v0 = sp[0], v1 = sp[1]; u32x4 w; w.x = cvtpk_s(v0[0], v0[1]); w.y = cvtpk_s(v0[2], v0[3]); w.z = cvtpk_s(v1[0], v1[1]); w.w = cvtpk_s(v1[2], v1[3]);
            *(u32x4*)(Ow + (size_t)row * D + ch * 8) = w; }
    }
}

struct KeyState { float m[4], l[4], o[4][8]; };
__device__ __forceinline__ void ks_init(KeyState& S) {
#pragma unroll
    for (int g = 0; g < 4; ++g) { S.m[g] = MINIT; S.l[g] = 0.f;
#pragma unroll
        for (int d = 0; d < 8; ++d) S.o[g][d] = 0.f; }
}
__device__ __forceinline__ void ks_key(KeyState& S, const float (&q)[4][8], const pg8::f32x4 k0, const pg8::f32x4 k1, const pg8::f32x4 v0, const pg8::f32x4 v1, bool valid) {
    float s[4];
#pragma unroll
    for (int g = 0; g < 4; ++g) { float a = q[g][0] * k0[0] + q[g][1] * k0[1] + q[g][2] * k0[2] + q[g][3] * k0[3] + q[g][4] * k1[0] + q[g][5] * k1[1] + q[g][6] * k1[2] + q[g][7] * k1[3];
        a += __shfl_xor(a, 1); a += __shfl_xor(a, 2); a += __shfl_xor(a, 4); s[g] = valid ? a : NEGINF; }
#pragma unroll
    for (int g = 0; g < 4; ++g) {
        if (s[g] > S.m[g] + THR) { const float al = __builtin_amdgcn_exp2f(S.m[g] - s[g]); S.m[g] = s[g]; S.l[g] *= al;
#pragma unroll
            for (int d = 0; d < 8; ++d) S.o[g][d] *= al; }
        const float p = __builtin_amdgcn_exp2f(s[g] - S.m[g]); S.l[g] += p;
#pragma unroll
        for (int d = 0; d < 4; ++d) { S.o[g][d] += p * v0[d]; S.o[g][4 + d] += p * v1[d]; }
    }
}
__device__ __forceinline__ void ks_merge_publish(KeyState& S, ALAS float* ML, ALAS float* MO, int wid, int lane) {
#pragma unroll
    for (int sh = 8; sh < 64; sh <<= 1) {
#pragma unroll
        for (int g = 0; g < 4; ++g) { const float mo = __shfl_xor(S.m[g], sh), lo = __shfl_xor(S.l[g], sh); const float mn = fmaxf(S.m[g], mo);
            const float a = __builtin_amdgcn_exp2f(S.m[g] - mn), bb = __builtin_amdgcn_exp2f(mo - mn); S.l[g] = S.l[g] * a + lo * bb;
#pragma unroll
            for (int d = 0; d < 8; ++d) { const float oo = __shfl_xor(S.o[g][d], sh); S.o[g][d] = S.o[g][d] * a + oo * bb; }
            S.m[g] = mn; }
    }
    if (lane < 8) {
#pragma unroll
        for (int g = 0; g < 4; ++g) { if (lane == 0) { ML[(wid * 4 + g) * 2] = S.m[g]; ML[(wid * 4 + g) * 2 + 1] = S.l[g]; }
#pragma unroll
            for (int d = 0; d < 8; ++d) MO[(wid * 4 + g) * 64 + lane * 8 + d] = S.o[g][d]; }
    }
}
__device__ __forceinline__ void ks_combine(ALAS float* ML, ALAS float* MO, ALAS float* RESb, int tid) {
    if (tid < 256) { const int g = tid >> 6, d = tid & 63; float M = MINIT;
#pragma unroll
        for (int w = 0; w < 8; ++w) M = fmaxf(M, ML[(w * 4 + g) * 2]);
        float Ls = 0.f, Os = 0.f;
#pragma unroll
        for (int w = 0; w < 8; ++w) { const float f = __builtin_amdgcn_exp2f(ML[(w * 4 + g) * 2] - M); Ls += ML[(w * 4 + g) * 2 + 1] * f; Os += MO[(w * 4 + g) * 64 + d] * f; }
        RESb[g * 64 + d] = Os / Ls; }
}

__device__ __forceinline__ void sample_unit(Frame& F, int bs, int h) {
    frame_fill(F);
    int tid = F.tid; asm volatile("" : "+v"(tid));
    const int lane = tid & 63, wid = F.wave, kl = lane >> 3, dp = lane & 7;
    ALAS char* L = (ALAS char*)F.lds;
    ALAS float* SC = (ALAS float*)(L + S_SC); ALAS float* PH = (ALAS float*)(L + S_PH); ALAS float* PBL = (ALAS float*)(L + S_PBL);
    ALAS int* SEL = (ALAS int*)(L + S_SEL); ALAS float* ML = (ALAS float*)(L + S_ML); ALAS float* MO = (ALAS float*)(L + S_MO); ALAS float* RES = (ALAS float*)(L + S_RES);
    const size_t row = (size_t)(MP + bs);
    float q[4][8];
#pragma unroll
    for (int g = 0; g < 4; ++g) { const u32x4 v = *(const u32x4*)(F.Qb + row * 512 + (4 * h + g) * 64 + dp * 8);
        q[g][0] = __uint_as_float(v.x << 16); q[g][1] = __uint_as_float(v.x & 0xffff0000u); q[g][2] = __uint_as_float(v.y << 16); q[g][3] = __uint_as_float(v.y & 0xffff0000u);
        q[g][4] = __uint_as_float(v.z << 16); q[g][5] = __uint_as_float(v.z & 0xffff0000u); q[g][6] = __uint_as_float(v.w << 16); q[g][7] = __uint_as_float(v.w & 0xffff0000u); }
    { const int c = 8 * wid + kl; const float* kc = F.KCVS + ((size_t)bs * 64 + c) * 256 + h * 64 + dp * 8;
      const pg8::f32x4 k0 = *(const pg8::f32x4*)kc, k1 = *(const pg8::f32x4*)(kc + 4);
#pragma unroll
      for (int g = 0; g < 4; ++g) { float a = q[g][0] * k0[0] + q[g][1] * k0[1] + q[g][2] * k0[2] + q[g][3] * k0[3] + q[g][4] * k1[0] + q[g][5] * k1[1] + q[g][6] * k1[2] + q[g][7] * k1[3];
          a += __shfl_xor(a, 1); a += __shfl_xor(a, 2); a += __shfl_xor(a, 4); if (dp == 0) SC[g * 64 + c] = a; } }
    __syncthreads();
    if (wid < 4) { const float s = SC[wid * 64 + lane]; float mx = s;
#pragma unroll
        for (int o = 1; o < 64; o <<= 1) mx = fmaxf(mx, __shfl_xor(mx, o));
        const float p = __builtin_amdgcn_exp2f(s - mx); const float sum = wave_sum(p); PH[wid * 64 + lane] = p / sum; }
    __syncthreads();
    if (wid == 0) {
        float pb = 0.f;
        if (lane < 32) pb = (PH[2 * lane] + PH[2 * lane + 1]) + (PH[64 + 2 * lane] + PH[64 + 2 * lane + 1]) + (PH[128 + 2 * lane] + PH[128 + 2 * lane + 1]) + (PH[192 + 2 * lane] + PH[192 + 2 * lane + 1]);
        const float sc = (lane <= 32) ? pb + ((lane == 0 || lane >= 31) ? 5.0f : 0.f) : NEGINF;
        const int key = (int)((__float_as_uint(sc) & ~63u) | (unsigned)(63 - lane));
        ((ALAS int*)PBL)[lane] = key;
        asm volatile("s_waitcnt lgkmcnt(0)" ::: "memory");
        unsigned rank = 0u;
        for (int j = 0; j < 33; ++j) rank += (unsigned)(key - ((ALAS int*)PBL)[j]) >> 31;
        const bool selb = (lane < 32) && (rank < 16u);
        const unsigned long long bal = __ballot(selb);
        if (selb) SEL[__popcll(bal & ((1ull << lane) - 1ull))] = lane;
        if (lane == 0) SEL[16] = __popcll(bal);
    }
    __syncthreads();
    const int nsel = SEL[16];
    if (tid < 256) { const int g = tid >> 6, d = tid & 63; const float* vc = F.KCVS + (size_t)bs * 64 * 256 + 128 + h * 64 + d; float a = 0.f;
#pragma unroll 8
        for (int c = 0; c < 64; ++c) a += PH[g * 64 + c] * vc[(size_t)c * 256];
        RES[g * 64 + d] = a; }
    KeyState S; ks_init(S);
    for (int e = wid; e < nsel; e += 8) {
        const int B = SEL[e]; const int page = F.page_table[bs * 16 + (B >> 1)];
        const float* base = F.cache_kv + ((size_t)page * 128 + (B & 1) * 64 + kl) * 512 + 256 + h * 64 + dp * 8;
#pragma unroll
        for (int half = 0; half < 2; ++half) {
            pg8::f32x4 kk[4][2], vv[4][2];
#pragma unroll
            for (int it = 0; it < 4; ++it) { const float* p = base + (size_t)((half * 4 + it) * 8) * 512;
                kk[it][0] = __builtin_nontemporal_load((const pg8::f32x4*)p); kk[it][1] = __builtin_nontemporal_load((const pg8::f32x4*)(p + 4));
                vv[it][0] = __builtin_nontemporal_load((const pg8::f32x4*)(p + 128)); vv[it][1] = __builtin_nontemporal_load((const pg8::f32x4*)(p + 132)); }
#pragma unroll
            for (int it = 0; it < 4; ++it) ks_key(S, q, kk[it][0], kk[it][1], vv[it][0], vv[it][1], true);
        }
    }
    if (wid == 0) {
        const float* p = F.out + O_KVS + (size_t)bs * 512 + 256 + h * 64 + dp * 8;
        ks_key(S, q, *(const pg8::f32x4*)p, *(const pg8::f32x4*)(p + 4), *(const pg8::f32x4*)(p + 128), *(const pg8::f32x4*)(p + 132), kl == 0);
    }
    ks_merge_publish(S, ML, MO, wid, lane);
    __syncthreads();
    ks_combine(ML, MO, RES + 256, tid);
    __syncthreads();
    ks_init(S);
    {
        const float* base = F.cache_win + ((size_t)bs * 512 + 64 * wid + kl) * 256 + h * 64 + dp * 8;
        float* ob = F.out + O_WINS + ((size_t)bs * 512 + 64 * wid + kl) * 256 + h * 64 + dp * 8;
#pragma unroll
        for (int half = 0; half < 2; ++half) {
            pg8::f32x4 kk[4][2], vv[4][2];
#pragma unroll
            for (int it = 0; it < 4; ++it) { const float* p = base + (size_t)((half * 4 + it) * 8) * 256;
                kk[it][0] = __builtin_nontemporal_load((const pg8::f32x4*)p); kk[it][1] = __builtin_nontemporal_load((const pg8::f32x4*)(p + 4));
                vv[it][0] = __builtin_nontemporal_load((const pg8::f32x4*)(p + 128)); vv[it][1] = __builtin_nontemporal_load((const pg8::f32x4*)(p + 132)); }
#pragma unroll
            for (int it = 0; it < 4; ++it) {
                const int j = 64 * wid + (half * 4 + it) * 8 + kl;
                if (j >= 1) { float* o = ob + (ptrdiff_t)((half * 4 + it) * 8 - 1) * 256; *(pg8::f32x4*)o = kk[it][0]; *(pg8::f32x4*)(o + 4) = kk[it][1]; *(pg8::f32x4*)(o + 128) = vv[it][0]; *(pg8::f32x4*)(o + 132) = vv[it][1]; }
                ks_key(S, q, kk[it][0], kk[it][1], vv[it][0], vv[it][1], true);
            }
        }
    }
    if (wid == 0) {
        const float* p = F.out + O_WINS + ((size_t)bs * 512 + 511) * 256 + h * 64 + dp * 8;
        ks_key(S, q, *(const pg8::f32x4*)p, *(const pg8::f32x4*)(p + 4), *(const pg8::f32x4*)(p + 128), *(const pg8::f32x4*)(p + 132), kl == 0);
    }
    ks_merge_publish(S, ML, MO, wid, lane);
    __syncthreads();
    ks_combine(ML, MO, RES + 512, tid);
    __syncthreads();
    if (tid < 256) { const int g = tid >> 6, d = tid & 63; const float* gt = F.GATE + row * 32 + (4 * h + g) * 3;
        const float v = gt[0] * RES[g * 64 + d] + gt[1] * RES[256 + g * 64 + d] + gt[2] * RES[512 + g * 64 + d];
        F.AO[row * D + 512 + (4 * h + g) * 64 + d] = (bf16)f2bf(v); }
    __syncthreads();
}

template <int ABL> __device__ __forceinline__ void attn_phase(Frame& F, int qword, int mode = 3) {
    ALAS unsigned* QS = (ALAS unsigned*)((ALAS char*)F.lds + A_QSLOT);
    frame_fill(F);
    unsigned mine = 0u;
    if (F.tid == 0) { QS[0] = __hip_atomic_fetch_add((unsigned*)(F.ctl + qword), 1u, __ATOMIC_RELAXED, __HIP_MEMORY_SCOPE_AGENT); }
    __syncthreads();
    for (;;) {
        const unsigned p = QS[0];
        __syncthreads();
        if (p >= 768u) break;
        frame_fill(F);
        if (F.tid == 0) mine = __hip_atomic_fetch_add((unsigned*)(F.ctl + qword), 1u, __ATOMIC_RELAXED, __HIP_MEMORY_SCOPE_AGENT);
        const unsigned k = p / 3u, r = p % 3u;
        if (r == 2u) { if (mode & 2) sample_unit(F, (int)(k >> 1), (int)(k & 1u)); }
        else if (mode & 1) { const unsigned u = 2u * k + r; prompt_unit<ABL>(F, (int)((u & 15u) >> 1), (int)(u & 1u), 31 - (int)(u >> 4)); }
        __syncthreads();
        if (F.tid == 0) QS[0] = mine;
        __syncthreads();
    }
}
#undef ALAS
}

struct Args { const void* in[19]; float* out; unsigned char* ws; int ph_lo, ph_hi, li, pad; };
__global__ void __launch_bounds__(NWAVES * 64, 2) mk_fwd(Args args) {
    extern __shared__ __attribute__((aligned(16))) unsigned char lds[];
    Frame F;
    F.lds = (LAS unsigned char*)lds;
    F.MISC = (volatile LAS unsigned*)(F.lds + MISC_OFF);
    F.tid = threadIdx.x; F.lane = F.tid & 63; F.wave = __builtin_amdgcn_readfirstlane(F.tid >> 6);
    F.G = gridDim.x; { const int bx = blockIdx.x; F.vcu = (F.G % 8 == 0) ? (bx % 8) * (F.G / 8) + bx / 8 : bx; }
    F.ka = (kptr_t)__builtin_amdgcn_kernarg_segment_ptr();
    frame_fill(F);
    for (int u = F.tid; u < (LDS_BYTES - LDSCTL_OFF) / 4; u += NWAVES * 64) ((LAS unsigned*)(F.lds + LDSCTL_OFF))[u] = 0u;
    __syncthreads();
    XcdBarrier bar; bar.bar = (unsigned*)(F.ctl + CW_BAR); bar.x = 0; bar.st = nullptr;
    if (N_LAUNCHES == 1) bar = xcd_barrier_post((unsigned*)(F.ctl + CW_BAR), F.MISC + 8);
#define GRID_BAR() do { if (N_LAUNCHES == 1) { xcd_barrier(bar); } } while (0)
    const int lo = args.ph_lo, hi = args.ph_hi;
#ifndef PH_MASK
#define PH_MASK 255
#endif
#define IN(k) (((PH_MASK >> (k)) & 1) && lo <= (k) && (k) < hi)
#define BOTH(k) (IN(k) && IN((k) + 1))

#ifndef REP_PHASE
#define REP_PHASE -1
#endif
#ifndef REP_ABL
#define REP_ABL 0
#endif
    if (IN(0)) { if (REP_PHASE == 0) { frame_fill(F); p0_prologue(F); GRID_BAR(); } frame_fill(F); p0_prologue(F); if (BOTH(0)) GRID_BAR(); }
    if (IN(1)) {
        frame_fill(F);
        pg8::Gemm g{F.XN, F.Win_t, MALL, NINP, D}; pg8::StaticOrder S; S.init(MALL, NINP, F.G, (int)blockIdx.x);
        pg8::EpiInProj E{F.Gb, F.Qb, F.KVb, F.GATE, F.out};
        if (REP_PHASE == 1) { pg8::gemm_phase<pg8::EpiInProj, pg8::StaticOrder, PG8_ALIGN, PG8_SP2>(F.lds + RING_OFF, g, S, E); GRID_BAR(); }
        pg8::gemm_phase<pg8::EpiInProj, pg8::StaticOrder, PG8_ALIGN, PG8_SP2>(F.lds + RING_OFF, g, S, E);
        frame_fill(F); spool_drain(F);
        if (BOTH(1)) GRID_BAR();
    }
    if (IN(2)) { if (REP_PHASE == 2) { frame_fill(F); p2_phase(F); GRID_BAR(); } frame_fill(F); p2_phase(F); if (BOTH(2)) GRID_BAR(); }
    if (IN(3)) { if (REP_PHASE == 3 || REP_PHASE == 31 || REP_PHASE == 32) { frame_fill(F); att::attn_phase<REP_ABL>(F, CW_QUEUE + 512, REP_PHASE == 3 ? 3 : REP_PHASE - 30); GRID_BAR(); } frame_fill(F); att::attn_phase<0>(F, CW_QUEUE); if (BOTH(3)) GRID_BAR(); }
    if (IN(4)) {
        frame_fill(F);
        pg8::Gemm g{F.AO, F.Wout_t, MP, D, D}; pg8::StaticOrder S; S.init(MP, D, F.G, (int)blockIdx.x);
        if (REP_PHASE == 4) { pg8::EpiOutProj E0{F.x_prompt, F.out + O_YP, F.HB, F.g_mlp, F.SS1 + 65536}; pg8::gemm_phase<pg8::EpiOutProj, pg8::StaticOrder, PG8_ALIGN, PG8_SP2>(F.lds + RING_OFF, g, S, E0); GRID_BAR(); frame_fill(F); }
        pg8::EpiOutProj E{F.x_prompt, F.out + O_YP, F.HB, F.g_mlp, F.SS1};
        pg8::gemm_phase<pg8::EpiOutProj, pg8::StaticOrder, PG8_ALIGN, PG8_SP2>(F.lds + RING_OFF, g, S, E);
        frame_fill(F);
        for (int it = F.vcu; it < 64; it += F.G) s_outproj_item(F, it);
        if (BOTH(4)) GRID_BAR();
    }
    if (IN(5)) {
        frame_fill(F);
        pg8::Gemm g{F.HB, F.Wup_t, MP, FF, D}; pg8::StaticOrder S; S.init(MP, FF, F.G, (int)blockIdx.x);
        pg8::EpiUp E{F.MID, F.SS1};
        if (REP_PHASE == 5) { pg8::gemm_phase<pg8::EpiUp, pg8::StaticOrder, PG8_ALIGN, PG8_SP2>(F.lds + RING_OFF, g, S, E); GRID_BAR(); }
        pg8::gemm_phase<pg8::EpiUp, pg8::StaticOrder, PG8_ALIGN, PG8_SP2>(F.lds + RING_OFF, g, S, E);
        frame_fill(F);
        for (int it = F.vcu; it < 256; it += F.G) s_up_item(F, it);
        if (REP_PHASE == 8) { GRID_BAR(); frame_fill(F); for (int it = F.vcu; it < 256; it += F.G) s_up_item(F, it); }
        if (BOTH(5)) GRID_BAR();
    }
    if (IN(6)) {
        frame_fill(F);
        pg8::Gemm g{F.MID, F.Wdn_t, MP, D, FF}; pg8::StaticOrder S; S.init(MP, D, F.G, (int)blockIdx.x);
        if (REP_PHASE == 6) { pg8::EpiDown E0{F.out + O_YP, (float*)(args.ws + WS_END), F.SS1 + 65536}; pg8::gemm_phase<pg8::EpiDown, pg8::StaticOrder, PG8_ALIGN, PG8_SP2>(F.lds + RING_OFF, g, S, E0); GRID_BAR(); frame_fill(F); }
        pg8::EpiDown E{F.out + O_YP, F.out + O_YP, F.SS2};
        pg8::gemm_phase<pg8::EpiDown, pg8::StaticOrder, PG8_ALIGN, PG8_SP2>(F.lds + RING_OFF, g, S, E);
        frame_fill(F);
        for (int it = F.vcu; it < 256; it += F.G) s_down_item(F, it);
        if (BOTH(6)) GRID_BAR();
    }
    if (IN(7)) { if (REP_PHASE == 7) { frame_fill(F); p7_phase(F, (float*)(args.ws + WS_END), (float*)(args.ws + WS_END) + (size_t)MP * D); GRID_BAR(); } frame_fill(F); p7_phase(F, F.out + O_YP, F.out + O_YS); }
#undef IN
#undef BOTH
#undef GRID_BAR
}

extern "C" void kernel_launch(void* const* d_in, const int* in_sizes, int n_in, void* d_out, int out_size, void* d_ws, size_t ws_size, hipStream_t stream) {
    static int grid = 0;
    if (grid == 0) {
        if (n_in != 19 || in_sizes[0] != MP * D || out_size != (int)O_END || ws_size < WS_END + 68 * MiB) {
            fprintf(stderr, "kernel_launch: unexpected problem (n_in %d, in0 %d, out %d, ws %zu); nothing launched\n", n_in, n_in > 0 ? in_sizes[0] : -1, out_size, ws_size); grid = -1; return; }
        int dev = 0, cus = 0, per_cu = 0;
        if (hipGetDevice(&dev) != hipSuccess || hipDeviceGetAttribute(&cus, hipDeviceAttributeMultiprocessorCount, dev) != hipSuccess) { fprintf(stderr, "kernel_launch: device query failed\n"); grid = -1; return; }
        if (hipFuncSetAttribute((const void*)mk_fwd, hipFuncAttributeMaxDynamicSharedMemorySize, LDS_BYTES) != hipSuccess) { fprintf(stderr, "kernel_launch: hipFuncSetAttribute failed\n"); grid = -1; return; }
        if (hipOccupancyMaxActiveBlocksPerMultiprocessor(&per_cu, (const void*)mk_fwd, NWAVES * 64, LDS_BYTES) != hipSuccess || per_cu < 1) {
            fprintf(stderr, "kernel_launch: occupancy query reports %d workgroups per CU; nothing launched\n", per_cu); (void)hipGetLastError(); grid = -1; return; }
        grid = cus;
    }
    if (grid < 0) return;
    if (hipMemsetAsync((char*)d_ws + WS_CTL, 0, CTL_ZERO_BYTES, stream) != hipSuccess) { fprintf(stderr, "kernel_launch: hipMemsetAsync failed\n"); return; }
    Args a{};
    for (int i = 0; i < 19; ++i) a.in[i] = d_in[i];
    a.out = (float*)d_out; a.ws = (unsigned char*)d_ws;
    for (int li = 0; li < N_LAUNCHES; ++li) {
        if (N_LAUNCHES == 1) { a.ph_lo = 0; a.ph_hi = N_PHASES; } else { a.ph_lo = li; a.ph_hi = li + 1; }
        a.li = li;
        hipLaunchKernelGGL(mk_fwd, dim3(grid), dim3(NWAVES * 64), LDS_BYTES, stream, a);
        const hipError_t le = hipPeekAtLastError();
        if (le != hipSuccess) { fprintf(stderr, "kernel_launch: launch %d failed: %s\n", li, hipGetErrorName(le)); break; }
    }
}
```
